# Optimizing an MI355X kernel written in HIP

```python
import math
import jax, jax.numpy as jnp
from jax import lax
import numpy as np

D_MODEL = 2048
BATCH = 4
SEQ = 2048
DEPTH = 2

SSM_WIDTH = D_MODEL // 2
SSM_GROUP = 16
SSM_GROUPS = SSM_WIDTH // SSM_GROUP
SSM_STATE = 64
DT_MIN = 0.001
DT_MAX = 0.1
ATTN_HEADS = 16
HEAD_DIM = 128
ATTN_WIDTH = ATTN_HEADS * HEAD_DIM
MOBA_BLOCK = 256
MOBA_TOPK = 3
Q_CHUNK = 16
ROT_DIM = HEAD_DIM // 4
ROPE_THETA = 500000.0
NORM_EPS = 1e-6
IN_SPLITS = (SSM_WIDTH, SSM_WIDTH, ATTN_WIDTH, ATTN_WIDTH, ATTN_WIDTH, ATTN_WIDTH, D_MODEL, D_MODEL)
IN_WIDTH = sum(IN_SPLITS)

kernel_name = "hybrid_s5_moba_gated_block"


def rms_norm(x, gain):
    xf = x.astype(jnp.float32)
    ms = jnp.mean(xf * xf, axis=-1, keepdims=True)
    return (xf * lax.rsqrt(ms + NORM_EPS) * gain.astype(jnp.float32)).astype(x.dtype)


def _complex_scan_op(e1, e2):
    a1r, a1i, b1r, b1i = e1
    a2r, a2i, b2r, b2i = e2
    return (a2r * a1r - a2i * a1i,
            a2r * a1i + a2i * a1r,
            a2r * b1r - a2i * b1i + b2r,
            a2r * b1i + a2i * b1r + b2i)


def s5_mixer(u, lam_re, lam_im, log_dt, b_re, b_im, c_re, c_im, d_skip):
    bsz, seq, _ = u.shape
    uf = u.astype(jnp.float32).reshape(bsz, seq, SSM_GROUPS, SSM_GROUP)
    lr = lam_re.astype(jnp.float32)
    li = lam_im.astype(jnp.float32)
    dt = jnp.exp(log_dt.astype(jnp.float32))[:, None]
    mag = jnp.exp(lr * dt)
    abar_re = mag * jnp.cos(li * dt)
    abar_im = mag * jnp.sin(li * dt)
    den = lr * lr + li * li
    nr = abar_re - 1.0
    ni = abar_im
    f_re = ((nr * lr + ni * li) / den)[..., None]
    f_im = ((ni * lr - nr * li) / den)[..., None]
    br = b_re.astype(jnp.float32)
    bi = b_im.astype(jnp.float32)
    bb_re = f_re * br - f_im * bi
    bb_im = f_re * bi + f_im * br
    bu_re = jnp.einsum('blgc,gpc->blgp', uf, bb_re)
    bu_im = jnp.einsum('blgc,gpc->blgp', uf, bb_im)
    full = bu_re.shape
    a_re = jnp.broadcast_to(abar_re, full)
    a_im = jnp.broadcast_to(abar_im, full)
    _, _, x_re, x_im = lax.associative_scan(_complex_scan_op, (a_re, a_im, bu_re, bu_im), axis=1)
    y = (jnp.einsum('blgp,gcp->blgc', x_re, c_re.astype(jnp.float32))
         - jnp.einsum('blgp,gcp->blgc', x_im, c_im.astype(jnp.float32))
         + d_skip.astype(jnp.float32).reshape(SSM_GROUPS, SSM_GROUP) * uf)
    return y.reshape(bsz, seq, SSM_WIDTH)


def partial_rope(t, cos, sin):
    half = ROT_DIM // 2
    t1 = t[..., :half]
    t2 = t[..., half:ROT_DIM]
    return jnp.concatenate([t1 * cos - t2 * sin, t2 * cos + t1 * sin, t[..., ROT_DIM:]], axis=-1)


def moba_attention(q, k, v):
    bsz, nh, seq, hd = q.shape
    nblk = -(-seq // MOBA_BLOCK)
    pad = nblk * MOBA_BLOCK - seq
    kp = jnp.pad(k, ((0, 0), (0, 0), (0, pad), (0, 0)))
    vp = jnp.pad(v, ((0, 0), (0, 0), (0, pad), (0, 0)))
    kb = kp.reshape(bsz, nh, nblk, MOBA_BLOCK, hd)
    vb = vp.reshape(bsz, nh, nblk, MOBA_BLOCK, hd)
    kmean = jnp.mean(kb.astype(jnp.float32), axis=3)
    ksel = min(MOBA_TOPK, nblk)
    n_chunks = seq // Q_CHUNK
    qc = q.reshape(bsz, nh, n_chunks, Q_CHUNK, hd).transpose(2, 0, 1, 3, 4)
    scale = 1.0 / math.sqrt(hd)
    b_ix = jnp.arange(bsz)[:, None, None, None]
    h_ix = jnp.arange(nh)[None, :, None, None]
    blk_ids = jnp.arange(nblk)

    def one_chunk(args):
        ci, qi = args
        q0 = ci * Q_CHUNK
        own = q0 // MOBA_BLOCK
        qpos = q0 + jnp.arange(Q_CHUNK)
        k_own = lax.dynamic_index_in_dim(kb, own, axis=2, keepdims=False)
        v_own = lax.dynamic_index_in_dim(vb, own, axis=2, keepdims=False)
        kpos = own * MOBA_BLOCK + jnp.arange(MOBA_BLOCK)
        s_own = jnp.einsum('bhqd,bhkd->bhqk', qi, k_own).astype(jnp.float32) * scale
        s_own = jnp.where(kpos[None, :] <= qpos[:, None], s_own, -jnp.inf)
        gate = jnp.einsum('bhqd,bhnd->bhqn', qi.astype(jnp.float32), kmean)
        gate = jnp.where(blk_ids < own, gate, -jnp.inf)
        _, idx = lax.top_k(gate, ksel)
        valid = idx < own
        k_sel = kb[b_ix, h_ix, idx]
        v_sel = vb[b_ix, h_ix, idx]
        s_sel = jnp.einsum('bhqd,bhqnkd->bhqnk', qi, k_sel).astype(jnp.float32) * scale
        s_sel = jnp.where(valid[..., None], s_sel, -jnp.inf)
        s_sel = s_sel.reshape(bsz, nh, Q_CHUNK, ksel * MOBA_BLOCK)
        p = jax.nn.softmax(jnp.concatenate([s_own, s_sel], axis=-1), axis=-1)
        p_own = p[..., :MOBA_BLOCK].astype(v.dtype)
        p_sel = p[..., MOBA_BLOCK:].reshape(bsz, nh, Q_CHUNK, ksel, MOBA_BLOCK).astype(v.dtype)
        o = (jnp.einsum('bhqk,bhkd->bhqd', p_own, v_own)
             + jnp.einsum('bhqnk,bhqnkd->bhqd', p_sel, v_sel))
        return o.astype(q.dtype)

    out = lax.map(one_chunk, (jnp.arange(n_chunks), qc))
    return out.transpose(1, 2, 0, 3, 4).reshape(bsz, nh, seq, hd)


def setup_inputs(seed: int = 0) -> dict:
    key = jax.random.key(seed)
    ks = jax.random.split(key, 20)
    f32 = jnp.float32
    L, G, P, GC = DEPTH, SSM_GROUPS, SSM_STATE, SSM_GROUP
    x = jax.random.normal(ks[0], (BATCH, SEQ, D_MODEL), f32)
    pre_norm = 1.0 + 0.02 * jax.random.normal(ks[1], (L, D_MODEL), f32)
    post_norm = 1.0 + 0.02 * jax.random.normal(ks[2], (L, D_MODEL), f32)
    w_in = jax.random.normal(ks[3], (L, D_MODEL, IN_WIDTH), f32) * D_MODEL ** -0.5
    n = jnp.arange(P, dtype=f32)
    lam_re = -0.5 + 0.01 * jax.random.normal(ks[4], (L, G, P), f32)
    lam_im = jnp.pi * n[None, None, :] + 0.01 * jax.random.normal(ks[5], (L, G, P), f32)
    log_dt = jax.random.uniform(ks[6], (L, G), f32, math.log(DT_MIN), math.log(DT_MAX))
    b_re = jax.random.normal(ks[7], (L, G, P, GC), f32) * (2.0 * GC) ** -0.5
    b_im = jax.random.normal(ks[8], (L, G, P, GC), f32) * (2.0 * GC) ** -0.5
    c_re = jax.random.normal(ks[9], (L, G, GC, P), f32) * (2.0 * P) ** -0.5
    c_im = jax.random.normal(ks[10], (L, G, GC, P), f32) * (2.0 * P) ** -0.5
    d_skip = jax.random.normal(ks[11], (L, SSM_WIDTH), f32) * 0.5
    w_glu = jax.random.normal(ks[12], (L, SSM_WIDTH, SSM_WIDTH), f32) * SSM_WIDTH ** -0.5
    b_glu = 0.01 * jax.random.normal(ks[13], (L, SSM_WIDTH), f32)
    w_br_ssm = jax.random.normal(ks[14], (L, SSM_WIDTH, D_MODEL), f32) * SSM_WIDTH ** -0.5
    w_br_attn = jax.random.normal(ks[15], (L, ATTN_WIDTH, D_MODEL), f32) * ATTN_WIDTH ** -0.5
    w_out = jax.random.normal(ks[16], (L, D_MODEL, D_MODEL), f32) * D_MODEL ** -0.5
    return {"x": x, "pre_norm": pre_norm, "post_norm": post_norm, "w_in": w_in,
            "lam_re": lam_re, "lam_im": lam_im, "log_dt": log_dt,
            "b_re": b_re, "b_im": b_im, "c_re": c_re, "c_im": c_im, "d_skip": d_skip,
            "w_glu": w_glu, "b_glu": b_glu, "w_br_ssm": w_br_ssm, "w_br_attn": w_br_attn,
            "w_out": w_out}


def reference(x, pre_norm, post_norm, w_in, lam_re, lam_im, log_dt, b_re, b_im, c_re, c_im,
              d_skip, w_glu, b_glu, w_br_ssm, w_br_attn, w_out):
    bsz, seq, _ = x.shape
    pos = jnp.arange(seq, dtype=jnp.float32)
    inv_freq = ROPE_THETA ** (-jnp.arange(0, ROT_DIM, 2, dtype=jnp.float32) / ROT_DIM)
    ang = pos[:, None] * inv_freq[None, :]
    cos = jnp.cos(ang).astype(x.dtype)
    sin = jnp.sin(ang).astype(x.dtype)
    split_at = [int(s) for s in np.cumsum(IN_SPLITS)[:-1]]

    for l in range(DEPTH):
        h = rms_norm(x, pre_norm[l])
        proj = h @ w_in[l]
        u_s, z_s, q, k, v, z_a, g_s, g_a = jnp.split(proj, split_at, axis=-1)

        y_s = s5_mixer(u_s, lam_re[l], lam_im[l], log_dt[l], b_re[l], b_im[l],
                       c_re[l], c_im[l], d_skip[l]).astype(x.dtype)
        y_s = jax.nn.gelu(y_s)
        y_s = y_s * jax.nn.sigmoid(y_s @ w_glu[l] + b_glu[l])
        o_s = y_s * jax.nn.silu(z_s)

        def heads(t):
            return t.reshape(bsz, seq, ATTN_HEADS, HEAD_DIM).transpose(0, 2, 1, 3)
        qh = partial_rope(heads(q), cos, sin)
        kh = partial_rope(heads(k), cos, sin)
        vh = heads(v)
        o_a = moba_attention(qh, kh, vh).transpose(0, 2, 1, 3).reshape(bsz, seq, ATTN_WIDTH)
        o_a = o_a * jax.nn.silu(z_a)

        merged = (jax.nn.sigmoid(g_s) * (o_s @ w_br_ssm[l])
                  + jax.nn.sigmoid(g_a) * (o_a @ w_br_attn[l]))
        out = merged @ w_out[l]
        x = x + rms_norm(out, post_norm[l])
    return x
```

```cpp
#include <hip/hip_runtime.h>
#include <cstdio>
#include <cstdint>
#include <cmath>

constexpr int D_MODEL = 2048, BATCH = 4, SEQ = 2048, DEPTH = 2;
constexpr int M = BATCH * SEQ;
constexpr int SSM_W = 1024, SSM_GC = 16, SSM_G = 64, SSM_P = 64;
constexpr int NH = 16, HD = 128, ATT_W = 2048;
constexpr int MOBA_BLK = 256, NBLK = SEQ / MOBA_BLK, TOPK = 3;
constexpr int ROT = 32, ROT_H = 16;
constexpr int IN_W = 14336;
constexpr int BR_K = SSM_W + ATT_W;
constexpr float EPS = 1e-6f;

#define GAS __attribute__((address_space(1)))
#define LAS __attribute__((address_space(3)))
typedef _Float16 half_t;
typedef _Float16 h8 __attribute__((ext_vector_type(8)));
typedef _Float16 h4 __attribute__((ext_vector_type(4)));
typedef _Float16 h2 __attribute__((ext_vector_type(2)));
typedef float f32x2 __attribute__((ext_vector_type(2)));
typedef float f32x4 __attribute__((ext_vector_type(4)));
typedef float f32x16 __attribute__((ext_vector_type(16)));
typedef unsigned u32x2 __attribute__((ext_vector_type(2)));
typedef unsigned u32x4 __attribute__((ext_vector_type(4)));
typedef GAS unsigned gu32;

__device__ __forceinline__ unsigned pk2h(float lo, float hi) { f32x2 v = {lo, hi}; h2 h = __builtin_convertvector(v, h2); return __builtin_bit_cast(unsigned, h); }
__device__ __forceinline__ u32x4 pk8h(f32x4 a, f32x4 b) { u32x4 w; w.x = pk2h(a[0], a[1]); w.y = pk2h(a[2], a[3]); w.z = pk2h(b[0], b[1]); w.w = pk2h(b[2], b[3]); return w; }
__device__ __forceinline__ void unpk8h(u32x4 w, f32x4& a, f32x4& b) { h8 h = __builtin_bit_cast(h8, w); a = (f32x4){(float)h[0], (float)h[1], (float)h[2], (float)h[3]}; b = (f32x4){(float)h[4], (float)h[5], (float)h[6], (float)h[7]}; }
__device__ __forceinline__ float fast_sigmoid(float x) { return __builtin_amdgcn_rcpf(1.f + __builtin_amdgcn_exp2f(-1.4426950408889634f * x)); }
__device__ __forceinline__ float fast_silu(float x) { return x * fast_sigmoid(x); }
__device__ __forceinline__ float gelu_tanh_f(float x) {
    const float u = 0.7978845608028654f * (x + 0.044715f * x * x * x); return x * fast_sigmoid(2.f * u); }
namespace pg8 {
#define PG8_LAS __attribute__((address_space(3)))
constexpr int BM = 256, BK = 64, HALF = 128, HTB = HALF * BK * 2  , STAGE_BYTES = 8 * HTB, NXCD = 8, WGM = 8;

__host__ __device__ __forceinline__ int lds_byte(int r, int c) { const int st = (r >> 4) * 2 + (c >> 5), rr = r & 15, cc = c & 31, ob = rr * 64 + cc * 2; return st * 1024 + (ob ^ (((ob >> 9) & 1) << 5)); }
__host__ __device__ __forceinline__ void stage_rc(int b, int& R, int& C) { const int st = b / 1024, sb = b % 1024, swz = sb ^ (((sb >> 9) & 1) << 5); R = (st >> 1) * 16 + swz / 64; C = (st & 1) * 32 + (swz % 64) / 2; }
__host__ __device__ __forceinline__ int perm32(int rho) { const int n = rho >> 4, i = rho & 15; return 8 * (i >> 2) + 4 * n + (i & 3); }

struct Unit { int pm, pn; };
struct Gemm { const half_t* A; const half_t* Bt; int M, N, K; };

struct StaticOrder {
    int nM, nN, nwg, G, c;
    __host__ __device__ void init(int M, int N, int G_, int c_) { nM = M / BM; nN = N / BM; nwg = nM * nN; G = G_; c = c_; }
    __host__ __device__ bool next(int i, Unit& u) const {
#ifdef EXP_REV_ORDER
        if ((long)i * G + c >= nwg) return false; const int nr_ = (nwg - c + G - 1) / G; const long L = (long)(nr_ - 1 - i) * G + c;
#else
        const long L = (long)i * G + c; if (L >= nwg) return false;
#endif
        int wgid = (int)L; { const int q = nwg / NXCD, r = nwg % NXCD, xcd = wgid % NXCD, off = wgid / NXCD; wgid = (xcd < r ? xcd * (q + 1) : r * (q + 1) + (xcd - r) * q) + off; }
        const int nig = WGM * nN, gid = wgid / nig, fm = gid * WGM, gsz = (nM - fm) < WGM ? (nM - fm) : WGM;
        u.pm = fm + ((wgid % nig) % gsz); u.pn = (wgid % nig) / gsz; return true;
    }
    __device__ __forceinline__ void a_ready(const Unit&) const {}
    __device__ __forceinline__ void done(const Unit&) const {}
};

typedef f32x4 acc_t[2][2][4][2];
constexpr int KMEAN_PART = BATCH * NH * NBLK * HD;
constexpr size_t EPI_MiB = 1u << 20, EPI_WS_U = 192 * EPI_MiB, EPI_WS_ZS = 208 * EPI_MiB, EPI_WS_Q = 224 * EPI_MiB, EPI_WS_QKV_STRIDE = 32 * EPI_MiB, EPI_WS_ZA = 320 * EPI_MiB, EPI_WS_G_STRIDE = 32 * EPI_MiB;
typedef __amdgpu_buffer_rsrc_t rsrc_t;
__device__ __forceinline__ rsrc_t mkrsrc(const void* p, size_t bytes) { return __builtin_amdgcn_make_buffer_rsrc((void*)p, (short)0, (int)bytes, 0x00020000); }
__device__ __forceinline__ u32x4 bld128(rsrc_t r, unsigned voff, unsigned soff) { return __builtin_amdgcn_raw_buffer_load_b128(r, voff, soff, 0); }
#ifndef ST_AUX
#define ST_AUX 0
#endif
__device__ __forceinline__ void bst128(u32x4 v, rsrc_t r, unsigned voff, unsigned soff) { __builtin_amdgcn_raw_buffer_store_b128(v, r, voff, soff, ST_AUX); }
__device__ __forceinline__ void bst128_wt(u32x4 v, rsrc_t r, unsigned voff, unsigned soff) { __builtin_amdgcn_raw_buffer_store_b128(v, r, voff, soff, 16); }
__device__ __forceinline__ void bst64(u32x2 v, rsrc_t r, unsigned voff, unsigned soff) { __builtin_amdgcn_raw_buffer_store_b64(v, r, voff, soff, ST_AUX); }

struct EpiIn {
    static constexpr bool PERM = false, AFTER_DRAIN = false, HAS_MID = false, A_GROUPED = false; static constexpr int MID_T = -1;
    unsigned char* ws; float* kmean; const float* rope;
    __device__ __forceinline__ void mid(acc_t&, const Unit&, int, int, int, int) const {}
    __device__ __forceinline__ void operator()(const acc_t& acc, const Unit& u, int wr, int wc, int fr, int fq) const {
        const int pn = u.pn, pm = u.pm;
        if (pn < 8 || pn >= 32) {
            size_t boff; int ldc, colt, act;
            if (pn < 4) { boff = EPI_WS_U; ldc = SSM_W; colt = pn * 256; act = 0; }
            else if (pn < 8) { boff = EPI_WS_ZS; ldc = SSM_W; colt = (pn - 4) * 256; act = 1; }
            else { boff = EPI_WS_ZA + (size_t)((pn - 32) >> 3) * EPI_WS_G_STRIDE; ldc = D_MODEL; colt = ((pn - 32) & 7) * 256; act = pn < 40 ? 1 : 2; }
            const rsrc_t rs = mkrsrc(ws + boff, (size_t)M * ldc * 2);
            const unsigned lo = (unsigned)((wr * 64 + fr) * ldc + wc * 32 + 8 * fq) * 2u, so0 = (unsigned)(pm * BM * ldc + colt) * 2u;
#pragma unroll
            for (int ai = 0; ai < 2; ++ai)
#pragma unroll
                for (int m = 0; m < 4; ++m) {
#pragma unroll
                    for (int bj = 0; bj < 2; ++bj) { f32x4 v0 = acc[ai][bj][m][0], v1 = acc[ai][bj][m][1];
                        if (act == 1) {
#pragma unroll
                            for (int e = 0; e < 4; ++e) { v0[e] = fast_silu(v0[e]); v1[e] = fast_silu(v1[e]); } }
                        else if (act == 2) {
#pragma unroll
                            for (int e = 0; e < 4; ++e) { v0[e] = fast_sigmoid(v0[e]); v1[e] = fast_sigmoid(v1[e]); } }
                        bst128(pk8h(v0, v1), rs, lo, so0 + (unsigned)((ai * HALF + m * 16) * ldc + bj * HALF) * 2u); } }
            return;
        }
        const int which = (pn - 8) >> 3, head0 = ((pn - 8) & 7) * 2, b = pm >> 3, blk = pm & 7;
        const rsrc_t rs = mkrsrc(ws + EPI_WS_Q + (size_t)which * EPI_WS_QKV_STRIDE, (size_t)M * ATT_W * 2), rr = mkrsrc(rope, (size_t)SEQ * 32 * 4);
        const bool rot = (which < 2) && (wc == 0);
        const unsigned lo = (unsigned)((wr * 64 + fr) * HD + (rot ? 4 * fq : wc * 32 + 8 * fq)) * 2u;
        const unsigned lr = (unsigned)((wr * 64 + fr) * 32 + 4 * fq) * 4u;
#pragma unroll
        for (int bj = 0; bj < 2; ++bj) {
            const unsigned sh = (unsigned)(((b * NH + head0 + bj) * SEQ + blk * 256) * HD) * 2u;
            f32x4 cs0 = {0.f, 0.f, 0.f, 0.f}, cs1 = {0.f, 0.f, 0.f, 0.f};
#pragma unroll
            for (int ai = 0; ai < 2; ++ai)
#pragma unroll
                for (int m = 0; m < 4; ++m) { const unsigned ro = (unsigned)(ai * HALF + m * 16);
                    f32x4 v0 = acc[ai][bj][m][0], v1 = acc[ai][bj][m][1];
                    if (rot) { const unsigned st = (unsigned)(blk * 256 + ro) * 128u;
                        const f32x4 c = __builtin_bit_cast(f32x4, bld128(rr, lr, st)), s = __builtin_bit_cast(f32x4, bld128(rr, lr, st + 64u));
                        const f32x4 o1 = v0 * c - v1 * s, o2 = v1 * c + v0 * s; v0 = o1; v1 = o2;
                        u32x2 w0 = {pk2h(v0[0], v0[1]), pk2h(v0[2], v0[3])}, w1 = {pk2h(v1[0], v1[1]), pk2h(v1[2], v1[3])};
                        bst64(w0, rs, lo, sh + ro * (HD * 2)); bst64(w1, rs, lo, sh + ro * (HD * 2) + 32u); }
                    else bst128(pk8h(v0, v1), rs, lo, sh + ro * (HD * 2));
                    cs0 += v0; cs1 += v1; }
            if (which == 1) {
#pragma unroll
                for (int o = 1; o < 16; o <<= 1)
#pragma unroll
                    for (int e = 0; e < 4; ++e) { cs0[e] += __shfl_xor(cs0[e], o); cs1[e] += __shfl_xor(cs1[e], o); }
                if (fr == 0) { float* km = kmean + (size_t)wr * KMEAN_PART + ((size_t)(b * NH + head0 + bj) * NBLK + blk) * HD;
                    const int d0 = rot ? 4 * fq : wc * 32 + 8 * fq, d1 = rot ? 16 + 4 * fq : wc * 32 + 8 * fq + 4;
                    const rsrc_t rk = mkrsrc(km, (size_t)HD * 4);
                    bst128(__builtin_bit_cast(u32x4, cs0 * (1.f / MOBA_BLK)), rk, (unsigned)d0 * 4u, 0u); bst128(__builtin_bit_cast(u32x4, cs1 * (1.f / MOBA_BLK)), rk, (unsigned)d1 * 4u, 0u); }
            }
        }
    }
};

struct EpiGlu {
    static constexpr bool PERM = false, AFTER_DRAIN = false, HAS_MID = false, A_GROUPED = true; static constexpr int MID_T = -1;
    const half_t *YS, *ZS; const float* bias; half_t* OSA;
    __device__ __forceinline__ void mid(acc_t&, const Unit&, int, int, int, int) const {}
    __device__ __forceinline__ void operator()(const acc_t& acc, const Unit& u, int wr, int wc, int fr, int fq) const {
        const rsrc_t ry = mkrsrc(YS, (size_t)M * SSM_W * 2), rz = mkrsrc(ZS, (size_t)M * SSM_W * 2), ro = mkrsrc(OSA, (size_t)M * BR_K * 2), rb = mkrsrc(bias, (size_t)SSM_W * 4);
        const unsigned li = (unsigned)((wr * 64 + fr) * SSM_W + wc * 32 + 8 * fq) * 2u, lo = (unsigned)((wr * 64 + fr) * BR_K + wc * 32 + 8 * fq) * 2u, lb = (unsigned)(wc * 32 + 8 * fq) * 4u;
        const unsigned ly = (unsigned)((((wc * 32 + 8 * fq) >> 4) * SEQ + wr * 64 + fr) * 32 + ((8 * fq) & 15) * 2);
        const unsigned si = (unsigned)(u.pm * BM * SSM_W + u.pn * BM) * 2u, so = (unsigned)(u.pm * BM * BR_K + u.pn * BM) * 2u, sb = (unsigned)(u.pn * BM) * 4u;
        const unsigned sy = (unsigned)((((u.pm >> 3) * SSM_G + u.pn * (BM / 16)) * SEQ + (u.pm & 7) * BM) * 32);
#pragma unroll
        for (int bj = 0; bj < 2; ++bj) { const f32x4 b0 = __builtin_bit_cast(f32x4, bld128(rb, lb, sb + bj * HALF * 4)), b1 = __builtin_bit_cast(f32x4, bld128(rb, lb, sb + bj * HALF * 4 + 16));
#pragma unroll
            for (int ai = 0; ai < 2; ++ai)
#pragma unroll
                for (int m = 0; m < 4; ++m) { const unsigned r = (unsigned)(ai * HALF + m * 16);
                    f32x4 y0, y1, z0, z1; unpk8h(bld128(ry, ly, sy + (unsigned)((bj * (HALF / 16) * SEQ + r) * 32)), y0, y1); unpk8h(bld128(rz, li, si + (r * SSM_W + bj * HALF) * 2u), z0, z1);
                    f32x4 v0 = acc[ai][bj][m][0] + b0, v1 = acc[ai][bj][m][1] + b1;
#pragma unroll
                    for (int e = 0; e < 4; ++e) { v0[e] = y0[e] * fast_sigmoid(v0[e]) * z0[e]; v1[e] = y1[e] * fast_sigmoid(v1[e]) * z1[e]; }
                    bst128(pk8h(v0, v1), ro, lo, so + (r * BR_K + bj * HALF) * 2u); } }
    }
};

struct EpiMerge {
    static constexpr bool PERM = false, AFTER_DRAIN = false, HAS_MID = true, A_GROUPED = false; static constexpr int MID_T = SSM_W / BK;
    const half_t *GS, *GA; half_t* MG;
    __device__ __forceinline__ void mid(acc_t& acc, const Unit& u, int wr, int wc, int fr, int fq) const {
        const rsrc_t rs = mkrsrc(GS, (size_t)M * D_MODEL * 2), ra = mkrsrc(GA, (size_t)M * D_MODEL * 2);
        const unsigned lo = (unsigned)((wr * 64 + fr) * D_MODEL + wc * 32 + 8 * fq) * 2u, so = (unsigned)(u.pm * BM * D_MODEL + u.pn * BM) * 2u;
#pragma unroll
        for (int ai = 0; ai < 2; ++ai)
#pragma unroll
            for (int m = 0; m < 4; ++m)
#pragma unroll
                for (int bj = 0; bj < 2; ++bj) { const unsigned o = so + (unsigned)((ai * HALF + m * 16) * D_MODEL + bj * HALF) * 2u;
                    f32x4 s0, s1, a0, a1; unpk8h(bld128(rs, lo, o), s0, s1); unpk8h(bld128(ra, lo, o), a0, a1);
#pragma unroll
                    for (int e = 0; e < 4; ++e) { acc[ai][bj][m][0][e] *= s0[e] * __builtin_amdgcn_rcpf(fmaxf(a0[e], 6.2e-5f)); acc[ai][bj][m][1][e] *= s1[e] * __builtin_amdgcn_rcpf(fmaxf(a1[e], 6.2e-5f)); } }
    }
    __device__ __forceinline__ void operator()(const acc_t& acc, const Unit& u, int wr, int wc, int fr, int fq) const {
        const rsrc_t ra = mkrsrc(GA, (size_t)M * D_MODEL * 2), rm = mkrsrc(MG, (size_t)M * D_MODEL * 2);
        const unsigned lo = (unsigned)((wr * 64 + fr) * D_MODEL + wc * 32 + 8 * fq) * 2u, so = (unsigned)(u.pm * BM * D_MODEL + u.pn * BM) * 2u;
#pragma unroll
        for (int ai = 0; ai < 2; ++ai)
#pragma unroll
            for (int m = 0; m < 4; ++m)
#pragma unroll
                for (int bj = 0; bj < 2; ++bj) { const unsigned o = so + (unsigned)((ai * HALF + m * 16) * D_MODEL + bj * HALF) * 2u;
                    f32x4 a0, a1; unpk8h(bld128(ra, lo, o), a0, a1); f32x4 v0 = acc[ai][bj][m][0], v1 = acc[ai][bj][m][1];
#pragma unroll
                    for (int e = 0; e < 4; ++e) { v0[e] *= fmaxf(a0[e], 6.2e-5f); v1[e] *= fmaxf(a1[e], 6.2e-5f); }
                    bst128(pk8h(v0, v1), rm, lo, o); }
    }
};

struct EpiOut {
    static constexpr bool PERM = false, AFTER_DRAIN = false, HAS_MID = false, A_GROUPED = false; static constexpr int MID_T = -1;
    half_t* OUT;
    __device__ __forceinline__ void mid(acc_t&, const Unit&, int, int, int, int) const {}
    __device__ __forceinline__ void operator()(const acc_t& acc, const Unit& u, int wr, int wc, int fr, int fq) const {
        const rsrc_t ro = mkrsrc(OUT, (size_t)M * D_MODEL * 2);
        const unsigned lo = (unsigned)((wr * 64 + fr) * D_MODEL + wc * 32 + 8 * fq) * 2u, so = (unsigned)(u.pm * BM * D_MODEL + u.pn * BM) * 2u;
#pragma unroll
        for (int ai = 0; ai < 2; ++ai)
#pragma unroll
            for (int m = 0; m < 4; ++m)
#pragma unroll
                for (int bj = 0; bj < 2; ++bj) { const unsigned o = so + (unsigned)((ai * HALF + m * 16) * D_MODEL + bj * HALF) * 2u;
                    bst128(pk8h(acc[ai][bj][m][0], acc[ai][bj][m][1]), ro, lo, o); }
    }
};
template <class Epi, class Sched, bool ALIGN_EPI = false, bool SP2 = false>
__device__ __forceinline__ void gemm_phase(PG8_LAS unsigned char* lds, const Gemm g, const Sched& S, const Epi& E) {
    int tid_ = threadIdx.x; asm volatile("" : "+v"(tid_));
    const int tid = tid_, wid = __builtin_amdgcn_readfirstlane(tid >> 6), lane = tid & 63, wr = wid >> 2, wc = wid & 3, fr = lane & 15, fq = lane >> 4;
    const int K = g.K, nt = K / BK;
    unsigned voffA[2], voffB[2];
#pragma unroll
    for (int i = 0; i < 2; ++i) { int R, C; stage_rc(tid * 16 + i * 8192, R, C); const int Rb = Epi::PERM ? ((R & ~31) + perm32(R & 31)) : R;
        voffA[i] = Epi::A_GROUPED ? (unsigned)(((C >> 4) * SEQ + R) * 32 + (C & 15) * 2) : (unsigned)(R * K + C) * 2u; voffB[i] = (unsigned)(Rb * K + C) * 2u; }
    const size_t kstep = (size_t)(BK * 2);
    const size_t hstep = (size_t)HALF * K * 2;
    const size_t tstep = 2 * hstep;
    const size_t kstepA = Epi::A_GROUPED ? (size_t)(BK / 16) * SEQ * 32 : kstep, hstepA = Epi::A_GROUPED ? (size_t)HALF * 32 : hstep;
#define PG8_ABASE(pm) (Epi::A_GROUPED ? (const char*)g.A + ((size_t)((pm) >> 3) * (K / 16) * SEQ + (size_t)((pm) & 7) * BM) * 32 : (const char*)g.A + (size_t)(pm) * tstep)
    const unsigned ldsw = (unsigned)wid * 1024u;
    const int aoff = lds_byte(wr * 64 + fr, fq * 8), boff = lds_byte(wc * 32 + fr, fq * 8);
#define PG8_SA(b, h) (((b) * 2 + (h)) * HTB)
#define PG8_SB(b, h) ((4 + (b) * 2 + (h)) * HTB)
#define PG8_STAGE(bufoff, gbase, voff) do { _Pragma("unroll") for (int _i = 0; _i < 2; ++_i) \
        __builtin_amdgcn_global_load_lds((const unsigned*)((const char*)(gbase) + (voff)[_i]), (PG8_LAS unsigned*)(lds + (bufoff) + ldsw + _i * 8192), 16, 0, 0); } while (0)
#define PG8_LDA(dst, b, h) do { _Pragma("unroll") for (int m = 0; m < 4; ++m) _Pragma("unroll") for (int k = 0; k < 2; ++k) dst[m][k] = *(const PG8_LAS h8*)(lds + PG8_SA(b, h) + aoff + m * 2048 + k * 1024); } while (0)
#define PG8_LDB(dst, b, h) do { _Pragma("unroll") for (int n = 0; n < 2; ++n) _Pragma("unroll") for (int k = 0; k < 2; ++k) dst[n][k] = *(const PG8_LAS h8*)(lds + PG8_SB(b, h) + boff + n * 2048 + k * 1024); } while (0)
#define PG8_MMA(ai, bj, At, Bt) do { __builtin_amdgcn_s_setprio(1); _Pragma("unroll") for (int m = 0; m < 4; ++m) _Pragma("unroll") for (int n = 0; n < 2; ++n) _Pragma("unroll") for (int k = 0; k < 2; ++k) \
        acc[ai][bj][m][n] = __builtin_amdgcn_mfma_f32_16x16x32_f16(Bt[n][k], At[m][k], acc[ai][bj][m][n], 0, 0, 0); __builtin_amdgcn_s_setprio(0); } while (0)
#define PG8_WAIT_V(n) asm volatile("s_waitcnt vmcnt(" #n ")" ::: "memory")
#define PG8_WAIT_L(n) asm volatile("s_waitcnt lgkmcnt(" #n ")" ::: "memory")
#define PG8_BAR __builtin_amdgcn_s_barrier()
#define PG8_SCHED __builtin_amdgcn_sched_barrier(0)
    Unit cur, nxt; int ui = 0;
    if (!S.next(0, cur)) return;
    f32x4 acc[2][2][4][2];
#pragma unroll
    for (int a = 0; a < 2; ++a)
#pragma unroll
        for (int b = 0; b < 2; ++b)
#pragma unroll
            for (int m = 0; m < 4; ++m)
#pragma unroll
                for (int n = 0; n < 2; ++n) acc[a][b][m][n] = (f32x4){0.f, 0.f, 0.f, 0.f};
    h8 At[4][2], B0[2][2], B1[2][2];
    const char* cA = PG8_ABASE(cur.pm); const char* cB = (const char*)g.Bt + (size_t)cur.pn * tstep;
    S.a_ready(cur);
    if constexpr (SP2) {
        PG8_STAGE(PG8_SB(0, 0), cB, voffB); PG8_STAGE(PG8_SB(0, 1), cB + hstep, voffB); PG8_STAGE(PG8_SA(0, 0), cA, voffA); PG8_STAGE(PG8_SA(0, 1), cA + hstepA, voffA);
        if (wr == 1) PG8_BAR;
        PG8_WAIT_V(2); PG8_BAR;
        PG8_STAGE(PG8_SB(1, 0), cB + kstep, voffB); PG8_STAGE(PG8_SA(1, 0), cA + kstepA, voffA); PG8_STAGE(PG8_SB(1, 1), cB + hstep + kstep, voffB);
        PG8_WAIT_V(6); PG8_BAR;
    } else {
        PG8_STAGE(PG8_SB(0, 0), cB, voffB); PG8_STAGE(PG8_SA(0, 0), cA, voffA); PG8_STAGE(PG8_SB(0, 1), cB + hstep, voffB); PG8_STAGE(PG8_SA(0, 1), cA + hstepA, voffA);
        if (wr == 1) PG8_BAR;
        PG8_WAIT_V(4); PG8_BAR;
        PG8_STAGE(PG8_SB(1, 0), cB + kstep, voffB); PG8_STAGE(PG8_SA(1, 0), cA + kstepA, voffA); PG8_STAGE(PG8_SB(1, 1), cB + hstep + kstep, voffB);
        PG8_WAIT_V(6); PG8_BAR;
    }
    for (;;) {
        const bool has_next = S.next(ui + 1, nxt);
        const char* nA = has_next ? PG8_ABASE(nxt.pm) : cA; const char* nB = has_next ? (const char*)g.Bt + (size_t)nxt.pn * tstep : cB;
        for (int t = 0; t < nt; t += 2) {
            if constexpr (Epi::HAS_MID) { if (t == Epi::MID_T) E.mid(acc, cur, wr, wc, fr, fq); }
            const bool last = (t == nt - 2);
            const char* a1 = cA + (size_t)(t + 1) * kstepA;
            const char* a2 = last ? nA : cA + (size_t)(t + 2) * kstepA; const char* b2 = last ? nB : cB + (size_t)(t + 2) * kstep;
            const char* a3 = a2 + kstepA; const char* b3 = b2 + kstep;
            if (last && has_next) S.a_ready(nxt);
            if constexpr (SP2) {
            PG8_LDB(B0, 0, 0); PG8_LDB(B1, 0, 1); PG8_SCHED; PG8_LDA(At, 0, 0); PG8_STAGE(PG8_SA(1, 1), a1 + hstepA, voffA);
            PG8_WAIT_V(8); PG8_WAIT_L(0); PG8_BAR; PG8_MMA(0, 0, At, B0); PG8_MMA(0, 1, At, B1); PG8_BAR; PG8_SCHED;
            PG8_LDA(At, 0, 1); PG8_STAGE(PG8_SB(0, 0), b2, voffB); PG8_STAGE(PG8_SB(0, 1), b2 + hstep, voffB); PG8_STAGE(PG8_SA(0, 0), a2, voffA);
            PG8_WAIT_V(8); PG8_WAIT_L(0); PG8_BAR; PG8_MMA(1, 0, At, B0); PG8_MMA(1, 1, At, B1); PG8_BAR; PG8_SCHED;
            PG8_LDB(B0, 1, 0); PG8_LDB(B1, 1, 1); PG8_SCHED; PG8_LDA(At, 1, 0); PG8_STAGE(PG8_SA(0, 1), a2 + hstepA, voffA);
            PG8_WAIT_V(8); PG8_WAIT_L(0); PG8_BAR; PG8_MMA(0, 0, At, B0); PG8_MMA(0, 1, At, B1); PG8_BAR; PG8_SCHED;
            PG8_LDA(At, 1, 1); PG8_STAGE(PG8_SB(1, 0), b3, voffB); PG8_STAGE(PG8_SB(1, 1), b3 + hstep, voffB); PG8_STAGE(PG8_SA(1, 0), a3, voffA);
            PG8_WAIT_V(8); PG8_WAIT_L(0); PG8_BAR; PG8_MMA(1, 0, At, B0); PG8_MMA(1, 1, At, B1); PG8_BAR; PG8_SCHED;
            } else {
            PG8_LDB(B0, 0, 0); PG8_SCHED; PG8_LDA(At, 0, 0); PG8_STAGE(PG8_SA(1, 1), a1 + hstepA, voffA);
            PG8_WAIT_L(8); PG8_BAR; PG8_WAIT_L(0); PG8_MMA(0, 0, At, B0); PG8_BAR; PG8_SCHED;
            PG8_LDB(B1, 0, 1); PG8_STAGE(PG8_SB(0, 0), b2, voffB);
            PG8_BAR; PG8_WAIT_L(0); PG8_MMA(0, 1, At, B1); PG8_BAR;
            PG8_LDA(At, 0, 1); PG8_STAGE(PG8_SA(0, 0), a2, voffA);
            PG8_BAR; PG8_WAIT_L(0); PG8_MMA(1, 0, At, B0); PG8_BAR; PG8_SCHED;
            PG8_STAGE(PG8_SB(0, 1), b2 + hstep, voffB);
            PG8_WAIT_V(6); PG8_BAR; PG8_MMA(1, 1, At, B1); PG8_BAR;
            PG8_LDB(B0, 1, 0); PG8_SCHED; PG8_LDA(At, 1, 0); PG8_STAGE(PG8_SA(0, 1), a2 + hstepA, voffA);
            PG8_WAIT_L(8); PG8_BAR; PG8_WAIT_L(0); PG8_MMA(0, 0, At, B0); PG8_BAR; PG8_SCHED;
            PG8_LDB(B1, 1, 1); PG8_STAGE(PG8_SB(1, 0), b3, voffB);
            PG8_BAR; PG8_WAIT_L(0); PG8_MMA(0, 1, At, B1); PG8_BAR;
            PG8_LDA(At, 1, 1); PG8_STAGE(PG8_SA(1, 0), a3, voffA);
            PG8_BAR; PG8_WAIT_L(0); PG8_MMA(1, 0, At, B0); PG8_BAR; PG8_SCHED;
            PG8_STAGE(PG8_SB(1, 1), b3 + hstep, voffB);
            PG8_WAIT_V(6); PG8_BAR; PG8_MMA(1, 1, At, B1); PG8_BAR;
            }
        }
        asm volatile("s_nop 15" :: "v"(At[3][1]), "v"(B0[1][1]), "v"(B1[1][1]));
        if constexpr (ALIGN_EPI) { if (wr == 0) PG8_BAR; }
        if constexpr (!Epi::AFTER_DRAIN) { E(acc, cur, wr, wc, fr, fq); S.done(cur); }
        if (!has_next) break;
#pragma unroll
        for (int a = 0; a < 2; ++a)
#pragma unroll
            for (int b = 0; b < 2; ++b)
#pragma unroll
                for (int m = 0; m < 4; ++m)
#pragma unroll
                    for (int n = 0; n < 2; ++n) acc[a][b][m][n] = (f32x4){0.f, 0.f, 0.f, 0.f};
        cur = nxt; cA = nA; cB = nB; ++ui;
        if constexpr (ALIGN_EPI) { if (wr == 1) PG8_BAR; }
    }
    PG8_WAIT_V(0);
    if constexpr (!ALIGN_EPI) { if (wr == 0) PG8_BAR; }
    PG8_BAR;
    if constexpr (Epi::AFTER_DRAIN) { E.fused(acc, cur, wr, wc, fr, fq, lds, wid, lane); S.done(cur); }
#undef PG8_ABASE
#undef PG8_SA
#undef PG8_SB
#undef PG8_STAGE
#undef PG8_LDA
#undef PG8_LDB
#undef PG8_MMA
#undef PG8_WAIT_V
#undef PG8_WAIT_L
#undef PG8_BAR
#undef PG8_SCHED
}

}

#define RLX_AGENT __ATOMIC_RELAXED, __HIP_MEMORY_SCOPE_AGENT
#define LDS_WAIT() asm volatile("s_waitcnt lgkmcnt(0)" ::: "memory")
#define VM_WAIT() asm volatile("s_waitcnt vmcnt(0)" ::: "memory")
#ifndef XB_SCOPE
#define XB_SCOPE "agent"
#endif
#ifndef XB_RELEASE_WBL2
#define XB_RELEASE_WBL2 1
#endif
#define XB_TMO      128
#define XB_XCNT(j)  (256  + 64 * (j))
#define XB_XSUB(j)  (1280 + 64 * (j))
#define XB_XGEN(j)  (2304 + 64 * (j))
#define XB_TOP      3328
#define XB_TOPGEN   3392
#define XCD_BAR_WORDS 3456
#define XB_SPIN_CAP (1u << 18)

__device__ __forceinline__ unsigned xb_ld(unsigned* p)              { return __hip_atomic_load(p, __ATOMIC_RELAXED, __HIP_MEMORY_SCOPE_AGENT); }
__device__ __forceinline__ unsigned xb_add(unsigned* p, unsigned v) { return __hip_atomic_fetch_add(p, v, __ATOMIC_RELAXED, __HIP_MEMORY_SCOPE_AGENT); }
__device__ __forceinline__ unsigned xb_xcc_id() { return (unsigned)__builtin_amdgcn_s_getreg((3 << 11) | 20) & 0xFu; }
#define XB_SPIN(cond, bar) do { unsigned _sp = 0; while (cond) { __builtin_amdgcn_s_sleep(1); \
    if ((++_sp & 255u) == 0u) { if (xb_ld(&(bar)[XB_TMO])) break; if (_sp > XB_SPIN_CAP) { atomicAdd(&(bar)[XB_TMO], 1u); break; } } } } while (0)

struct XcdBarrier {
    unsigned* bar; unsigned x;
    volatile LAS unsigned* st;
};

__device__ __forceinline__ XcdBarrier xcd_barrier_post(unsigned* bar, volatile LAS unsigned* st) {
    XcdBarrier b; b.bar = bar; b.x = xb_xcc_id(); b.st = st;
    if (threadIdx.x == 0) (void)xb_add(&bar[XB_XCNT(b.x)], 1u);
    return b;
}
__device__ __forceinline__ void xcd_barrier_complete(unsigned* bar, unsigned x, unsigned& nloc, unsigned& nx) {
    const unsigned G = gridDim.x * gridDim.y * gridDim.z;
    unsigned sum, cnt, mine, sp = 0u;
    for (;;) {
        sum = 0u; cnt = 0u; mine = 0u;
#pragma unroll
        for (unsigned j = 0; j < 16; ++j) { const unsigned c = xb_ld(&bar[XB_XCNT(j)]); sum += c; cnt += (c > 0u) ? 1u : 0u; mine = (j == x) ? c : mine; }
        if (sum == G) break;
        __builtin_amdgcn_s_sleep(1);
        if ((++sp & 255u) == 0u) { if (xb_ld(&bar[XB_TMO])) break; if (sp > XB_SPIN_CAP) { atomicAdd(&bar[XB_TMO], 1u); break; } }
    }
    nloc = mine > 0u ? mine : 1u; nx = cnt > 0u ? cnt : 1u;
}

__device__ __forceinline__ void xcd_barrier(const XcdBarrier& b) {
    asm volatile("s_waitcnt vmcnt(0)" ::: "memory");
    __syncthreads();
    if (threadIdx.x == 0) {
        unsigned* bar = b.bar;
        __builtin_amdgcn_s_waitcnt(0);
        unsigned nloc = b.st[0], nx = b.st[1];
        if (nloc == 0u) { xcd_barrier_complete(bar, b.x, nloc, nx); b.st[0] = nloc; b.st[1] = nx; }
        const unsigned old = xb_add(&bar[XB_XSUB(b.x)], 1u);
        const unsigned gen = old / nloc;
        if (old + 1u == (gen + 1u) * nloc) {
#if XB_RELEASE_WBL2
            __builtin_amdgcn_fence(__ATOMIC_RELEASE, XB_SCOPE);
#endif
            asm volatile("s_waitcnt vmcnt(0)" ::: "memory");
            const unsigned og = xb_add(&bar[XB_TOP], 1u);
            const unsigned tg = og / nx;
            if (og + 1u == (tg + 1u) * nx) xb_add(&bar[XB_TOPGEN], 1u);
            else XB_SPIN(xb_ld(&bar[XB_TOPGEN]) == tg, bar);
            __builtin_amdgcn_fence(__ATOMIC_ACQUIRE, XB_SCOPE);
            xb_add(&bar[XB_XGEN(b.x)], 1u);
            asm volatile("s_waitcnt vmcnt(0)" ::: "memory");
        } else {
            XB_SPIN(xb_ld(&bar[XB_XGEN(b.x)]) == gen, bar);
            __builtin_amdgcn_fence(__ATOMIC_ACQUIRE, XB_SCOPE);
            asm volatile("s_waitcnt vmcnt(0)" ::: "memory");
        }
    }
    __syncthreads();
}

constexpr size_t MiB = 1u << 20;
constexpr size_t WS_CTL = 0, CTL_ZERO_BYTES = 1 * MiB;
constexpr size_t WS_KMEAN = 1 * MiB + 512 * 1024;
constexpr size_t WS_ROPE = 1 * MiB;
constexpr size_t WS_S5 = 2 * MiB, S5_STRIDE = 1 * MiB;
constexpr size_t S5_A = 0, S5_BB = 64 * 1024, S5_CM = 320 * 1024, S5_SC = 576 * 1024;
constexpr size_t WS_WIN = 4 * MiB, WIN_STRIDE = 56 * MiB;
constexpr size_t WS_WGLU = 116 * MiB, WGLU_STRIDE = 2 * MiB;
constexpr size_t WS_WBR = 120 * MiB, WBR_STRIDE = 12 * MiB;
constexpr size_t WS_WOUT = 144 * MiB, WOUT_STRIDE = 8 * MiB;
constexpr size_t WS_XN = 160 * MiB, WS_U = 192 * MiB, WS_ZS = 208 * MiB, WS_Q = 224 * MiB, WS_K = 256 * MiB, WS_V = 288 * MiB;
constexpr size_t WS_ZA = 320 * MiB, WS_GS = 352 * MiB, WS_GA = 384 * MiB, WS_YS = 416 * MiB, WS_OSA = 432 * MiB, WS_MG = 480 * MiB, WS_OUT = 512 * MiB;
constexpr size_t WS_XST = 576 * MiB, WS_END = 832 * MiB;
static_assert(pg8::EPI_WS_U == WS_U && pg8::EPI_WS_ZS == WS_ZS && pg8::EPI_WS_Q == WS_Q && WS_K == WS_Q + pg8::EPI_WS_QKV_STRIDE && WS_V == WS_K + pg8::EPI_WS_QKV_STRIDE && pg8::EPI_WS_ZA == WS_ZA && WS_GS == WS_ZA + pg8::EPI_WS_G_STRIDE && WS_GA == WS_GS + pg8::EPI_WS_G_STRIDE, "EpiIn offsets");
constexpr int CW_TMO = 0, CW_CODE = 1, CW_BAR = 4096;

constexpr int RING_OFF = 0, RING_BYTES = 155648;
constexpr int LDSCTL_OFF = RING_BYTES, MISC_OFF = LDSCTL_OFF + 320;
constexpr int LDS_BYTES = 163840;
constexpr int NWAVES = 8;


namespace s5 {
#ifndef S5_UPITCH
#define S5_UPITCH SSM_W
#endif
constexpr int XROW = 304;
constexpr int X_BYTES = 32 * XROW, LDS_E = 8 * X_BYTES, LDS_U = LDS_E + 16 * 64 * 8, LDS_BYTES_S5 = LDS_U + SEQ * 32;
__device__ __forceinline__ void unit(LAS unsigned char* lds, int b, int g, const half_t* U, half_t* YS, const unsigned char* tab, const float* dskip, const float* logdt) {
    int tid_ = threadIdx.x; asm volatile("" : "+v"(tid_));
    const int lane = tid_ & 63, wave = __builtin_amdgcn_readfirstlane(tid_ >> 6);
    const int c = lane & 31, h = lane >> 5, c16 = lane & 15, q4 = lane >> 4;
    const f32x4 A0 = ((const f32x4*)(tab + S5_A))[g * 64 + c], A1 = ((const f32x4*)(tab + S5_A))[g * 64 + 32 + c];
    h8 bbf[4], cmf[4];
#pragma unroll
    for (int t = 0; t < 4; ++t) bbf[t] = *(const h8*)((const half_t*)(tab + S5_BB) + ((size_t)(g * 128 + t * 32 + c) * 16 + 8 * h));
#pragma unroll
    for (int ks = 0; ks < 4; ++ks) cmf[ks] = *(const h8*)((const half_t*)(tab + S5_CM) + ((size_t)(g * 16 + c16) * 128 + 32 * ks + 8 * q4));
    const float isc = 1.f / exp2f(rintf(-logdt[g] * 1.4426950408889634f)), dsk = dskip[g * 16 + c16];
    const int r = lane & 31, s_in = (r >> 2) & 1, j_in = (r & 3) + 4 * (r >> 3);
    LAS unsigned char* Ut = lds + LDS_U;
    {
        const half_t* ub = U + (size_t)b * SEQ * S5_UPITCH + g * 16;
#ifdef S5_U_DMA
#pragma unroll
        for (int i = 0; i < 8; ++i) { const int p = tid_ + 512 * i;
            __builtin_amdgcn_global_load_lds((const unsigned*)(ub + (size_t)(p >> 1) * S5_UPITCH + 8 * (p & 1)), (LAS unsigned*)(Ut + 16 * (wave * 64 + 512 * i)), 16, 0, 0); }
        asm volatile("s_waitcnt vmcnt(0)" ::: "memory");
#else
        h8 t[8];
#pragma unroll
        for (int i = 0; i < 8; ++i) { const int p = tid_ + 512 * i; t[i] = *(const h8*)(ub + (size_t)(p >> 1) * S5_UPITCH + 8 * (p & 1)); }
#pragma unroll
        for (int i = 0; i < 8; ++i) *(LAS h8*)(Ut + 16 * (tid_ + 512 * i)) = t[i];
#endif
    }
    __syncthreads();
    const LAS unsigned char* urow = Ut + (128 * (2 * wave + s_in) + j_in) * 32 + 16 * h;
    LAS unsigned char* Xw = lds + wave * X_BYTES;
    LAS f32x2* E = (LAS f32x2*)(lds + LDS_E);
    const f32x16 z16 = {0.f, 0.f, 0.f, 0.f, 0.f, 0.f, 0.f, 0.f, 0.f, 0.f, 0.f, 0.f, 0.f, 0.f, 0.f, 0.f};
    float x0r = 0.f, x0i = 0.f, x1r = 0.f, x1i = 0.f;
#pragma unroll 1
    for (int it = 0; it < 8; ++it) {
        const h8 a = *(const LAS h8*)(urow + it * 512);
        const f32x16 b0 = __builtin_amdgcn_mfma_f32_32x32x16_f16(a, bbf[0], z16, 0, 0, 0), b1 = __builtin_amdgcn_mfma_f32_32x32x16_f16(a, bbf[1], z16, 0, 0, 0);
        const f32x16 b2 = __builtin_amdgcn_mfma_f32_32x32x16_f16(a, bbf[2], z16, 0, 0, 0), b3 = __builtin_amdgcn_mfma_f32_32x32x16_f16(a, bbf[3], z16, 0, 0, 0);
        asm volatile("s_nop 15\n\ts_nop 15\n\ts_nop 15" :: "v"(a));
#pragma unroll
        for (int i = 0; i < 16; ++i) {
            const float n0r = fmaf(A0.x, x0r, fmaf(-A0.y, x0i, b0[i])), n0i = fmaf(A0.x, x0i, fmaf(A0.y, x0r, b2[i])); x0r = n0r; x0i = n0i;
            const float n1r = fmaf(A1.x, x1r, fmaf(-A1.y, x1i, b1[i])), n1i = fmaf(A1.x, x1i, fmaf(A1.y, x1r, b3[i])); x1r = n1r; x1i = n1i; }
    }
    E[(2 * wave + h) * 64 + c] = (f32x2){x0r, x0i}; E[(2 * wave + h) * 64 + 32 + c] = (f32x2){x1r, x1i};
    __syncthreads();
    x0r = 0.f; x0i = 0.f; x1r = 0.f; x1i = 0.f;
    for (int kk = 0; kk < 2 * wave + h; ++kk) { const f32x2 e0 = E[kk * 64 + c], e1 = E[kk * 64 + 32 + c];
        const float n0r = A0.z * x0r - A0.w * x0i + e0.x, n0i = A0.z * x0i + A0.w * x0r + e0.y; x0r = n0r; x0i = n0i;
        const float n1r = A1.z * x1r - A1.w * x1i + e1.x, n1i = A1.z * x1i + A1.w * x1r + e1.y; x1r = n1r; x1i = n1i; }
    const pg8::rsrc_t ry = pg8::mkrsrc(YS + (size_t)(b * SSM_G + g) * SEQ * 16, (size_t)SEQ * 32);
    const unsigned yl = (unsigned)((128 * (2 * wave + (lane >> 5)) + ((lane & 31) >> 1)) * 32 + (lane & 1) * 16);
    h8 dmf;
#pragma unroll
    for (int j = 0; j < 8; ++j) dmf[j] = (q4 < 2 && 8 * q4 + j == c16) ? (half_t)(dsk / isc) : (half_t)0.f;
    LAS unsigned char* xu = Xw + (16 * s_in + j_in) * XROW + 256 + 16 * h;
#pragma unroll 1
    for (int it = 0; it < 8; ++it) {
        const h8 a = *(const LAS h8*)(urow + it * 512);
        const f32x16 b0 = __builtin_amdgcn_mfma_f32_32x32x16_f16(a, bbf[0], z16, 0, 0, 0), b1 = __builtin_amdgcn_mfma_f32_32x32x16_f16(a, bbf[1], z16, 0, 0, 0);
        const f32x16 b2 = __builtin_amdgcn_mfma_f32_32x32x16_f16(a, bbf[2], z16, 0, 0, 0), b3 = __builtin_amdgcn_mfma_f32_32x32x16_f16(a, bbf[3], z16, 0, 0, 0);
        asm volatile("s_nop 15\n\ts_nop 15\n\ts_nop 15" :: "v"(a));
        *(LAS h8*)xu = a;
#pragma unroll
        for (int i = 0; i < 16; ++i) {
            const float n0r = fmaf(A0.x, x0r, fmaf(-A0.y, x0i, b0[i])), n0i = fmaf(A0.x, x0i, fmaf(A0.y, x0r, b2[i])); x0r = n0r; x0i = n0i;
            const float n1r = fmaf(A1.x, x1r, fmaf(-A1.y, x1i, b1[i])), n1i = fmaf(A1.x, x1i, fmaf(A1.y, x1r, b3[i])); x1r = n1r; x1i = n1i;
            *(LAS unsigned*)(Xw + (16 * h + i) * XROW + 4 * c) = pk2h(x0r, x0i); *(LAS unsigned*)(Xw + (16 * h + i) * XROW + 128 + 4 * c) = pk2h(x1r, x1i); }
        asm volatile("s_waitcnt lgkmcnt(0)" ::: "memory");
        f32x4 y0 = {0.f, 0.f, 0.f, 0.f}, y1 = {0.f, 0.f, 0.f, 0.f};
#pragma unroll
        for (int ks = 0; ks < 4; ++ks) {
            const h8 f0 = *(const LAS h8*)(Xw + c16 * XROW + (32 * ks + 8 * q4) * 2), f1 = *(const LAS h8*)(Xw + (16 + c16) * XROW + (32 * ks + 8 * q4) * 2);
            y0 = __builtin_amdgcn_mfma_f32_16x16x32_f16(f0, cmf[ks], y0, 0, 0, 0); y1 = __builtin_amdgcn_mfma_f32_16x16x32_f16(f1, cmf[ks], y1, 0, 0, 0); asm volatile("" :: "v"(f0), "v"(f1)); }
        {
            const h8 f0 = *(const LAS h8*)(Xw + c16 * XROW + 256 + 16 * (q4 & 1)), f1 = *(const LAS h8*)(Xw + (16 + c16) * XROW + 256 + 16 * (q4 & 1));
            y0 = __builtin_amdgcn_mfma_f32_16x16x32_f16(f0, dmf, y0, 0, 0, 0); y1 = __builtin_amdgcn_mfma_f32_16x16x32_f16(f1, dmf, y1, 0, 0, 0); asm volatile("s_nop 15\n\ts_nop 15" :: "v"(f0), "v"(f1)); }
        asm volatile("s_waitcnt lgkmcnt(0)" ::: "memory");
#pragma unroll
        for (int e = 0; e < 4; ++e) { *(LAS half_t*)(Xw + (4 * q4 + e) * 32 + c16 * 2) = (half_t)gelu_tanh_f(y0[e] * isc); *(LAS half_t*)(Xw + (16 + 4 * q4 + e) * 32 + c16 * 2) = (half_t)gelu_tanh_f(y1[e] * isc); }
        asm volatile("s_waitcnt lgkmcnt(0)" ::: "memory");
        pg8::bst128(*(const LAS u32x4*)(Xw + lane * 16), ry, yl, (unsigned)(it * 16 * 32));
        asm volatile("s_waitcnt lgkmcnt(0)" ::: "memory");
    }
    __syncthreads();
}
}

namespace attn {
constexpr int D = 128, NW = 8, QBLK = 32, KVBLK = 64, QB = NW * QBLK;
constexpr float SCALE = 0.08838834764831845f, THR = 8.f;
constexpr int SHM_V = KVBLK * D * 2, SHM_K = KVBLK * D * 2;
constexpr int OST_OFF = 2 * SHM_V + 2 * SHM_K + NW * 64 * 4, OST_ROW = 272, OST_WAVE = 32 * OST_ROW;
constexpr int LDS_BYTES_ATT = OST_OFF + NW * OST_WAVE;
typedef short s16x4 __attribute__((ext_vector_type(4)));
#define KSWZ(row, colB) ((row) * 256 + ((colB) ^ (((row) & 7) << 4)))
#define SBAR() __builtin_amdgcn_sched_barrier(0)
#define MFMA_SRC_GUARD2(x, y) asm volatile("s_nop 15\n\ts_nop 15" :: "v"(x), "v"(y))
__device__ __forceinline__ int v_st(int k, int c) { const int kk = (k & ~0xC) | ((k & 4) << 1) | ((k & 8) >> 1); return ((kk >> 3) * 4 + (c >> 5)) * 512 + ((kk & 7) * 32 + (c & 31)) * 2; }
__device__ __forceinline__ int v_rd_base(int lane) { return ((lane & 3) << 3) | (((lane >> 2) & 3) << 6) | (((lane >> 4) & 1) << 5) | (((lane >> 5) & 1) << 8); }
constexpr int v_rd_off(int d0, int ks, int half) { return d0 * 512 + ks * 4096 + half * 2048; }
__device__ __forceinline__ int crow(int r, int hi) { return (r & 3) + 8 * (r >> 2) + 4 * hi; }
__device__ __forceinline__ h8 load8(const half_t* p) { return *reinterpret_cast<const h8*>(p); }
__device__ __forceinline__ void mask_tile(f32x16& p0, f32x16& p1, int dq) {
    const float NEG = -__builtin_inff();
#pragma unroll
    for (int r = 0; r < 16; ++r) { const int c = (r & 3) + 8 * (r >> 2); if (dq - c < 0) p0[r] = NEG; if (dq - c - 32 < 0) p1[r] = NEG; }
}
__device__ __forceinline__ void partialSM(f32x16& p0, f32x16& p1, float& m_reg, float& mn, float& alpha, bool sel) {
    float pmax = p0[0]; for (int r = 1; r < 16; ++r) pmax = fmaxf(pmax, p0[r]); for (int r = 0; r < 16; ++r) pmax = fmaxf(pmax, p1[r]);
    { auto rr = __builtin_amdgcn_permlane32_swap(__float_as_uint(pmax), __float_as_uint(pmax), false, false);
      pmax = fmaxf(__uint_as_float(rr[0]), __uint_as_float(rr[1])); }
    pmax = sel ? pmax : -__builtin_inff();
    constexpr float C2 = 1.4426950408889634f * SCALE;
    if (__builtin_expect(__all((pmax - m_reg) * SCALE <= THR), 1)) { mn = m_reg; alpha = 1.f; }
    else { mn = fmaxf(m_reg, pmax); alpha = __builtin_amdgcn_exp2f((m_reg - mn) * C2); m_reg = mn; }
    const float mnL = sel ? -mn * C2 : -__builtin_inff();
    for (int r = 0; r < 16; ++r) p0[r] = fmaf(p0[r], C2, mnL); for (int r = 0; r < 16; ++r) p1[r] = fmaf(p1[r], C2, mnL);
    for (int r = 0; r < 16; ++r) p0[r] = __builtin_amdgcn_exp2f(p0[r]);
}
__device__ __forceinline__ void finishSM(f32x16& p0, f32x16& p1, float alpha, float& l_reg, h8& pa0, h8& pa1, h8& pa2, h8& pa3) {
    for (int r = 0; r < 16; ++r) p1[r] = __builtin_amdgcn_exp2f(p1[r]);
    float ps = 0; for (int r = 0; r < 16; ++r) ps += p0[r]; for (int r = 0; r < 16; ++r) ps += p1[r];
    { auto rr = __builtin_amdgcn_permlane32_swap(__float_as_uint(ps), __float_as_uint(ps), false, false);
      ps = __uint_as_float(rr[0]) + __uint_as_float(rr[1]); }
    l_reg = l_reg * alpha + ps;
#define PK4(P, B_, OUT) do { unsigned a0 = pk2h(P[B_+0], P[B_+1]), a1 = pk2h(P[B_+2], P[B_+3]);                          \
        unsigned b0 = pk2h(P[B_+4], P[B_+5]), b1 = pk2h(P[B_+6], P[B_+7]);                                             \
        auto r0 = __builtin_amdgcn_permlane32_swap(a0, b0, false, false); auto r1 = __builtin_amdgcn_permlane32_swap(a1, b1, false, false); \
        u32x4 w = {r0[0], r1[0], r0[1], r1[1]}; OUT = __builtin_bit_cast(h8, w); } while (0)
    PK4(p0, 0, pa0); PK4(p0, 8, pa1); PK4(p1, 0, pa2); PK4(p1, 8, pa3);
#undef PK4
}
template <int KB>
__device__ __forceinline__ void qkt(f32x16& p0, f32x16& p1, const char* K_lds, int r32, int hi, const h8* qr) {
    p0 = f32x16{}; p1 = f32x16{}; asm volatile("" : "+v"(p0), "+v"(p1));
    const char* kb[4];
#pragma unroll
    for (int dd = 0; dd < 4; ++dd) kb[dd] = K_lds + KB * SHM_K + KSWZ(r32, (dd * 16 + hi * 8) * 2);
    h8 b0, b1;
#pragma unroll
    for (int d0 = 0; d0 < 8; ++d0) { const char* a = kb[d0 & 3] + (d0 >> 2) * 128;
        b0 = *reinterpret_cast<const h8*>(a);
        b1 = *reinterpret_cast<const h8*>(a + 32 * 256);
        p0 = __builtin_amdgcn_mfma_f32_32x32x16_f16(b0, qr[d0], p0, 0, 0, 0);
        p1 = __builtin_amdgcn_mfma_f32_32x32x16_f16(b1, qr[d0], p1, 0, 0, 0); }
    MFMA_SRC_GUARD2(b0, b1);
}
template <int VB>
__device__ __forceinline__ void pv_tile(f32x16* o, int vb0, h8 pa0, h8 pa1, h8 pa2, h8 pa3) {
#define TRRD(dst, off) asm volatile("ds_read_b64_tr_b16 %0, %1 offset:%2" : "=&v"(dst) : "v"(vb0), "i"(off) : "memory")
#define MKB(l, h) __builtin_bit_cast(h8, (short __attribute__((ext_vector_type(8)))){l[0], l[1], l[2], l[3], h[0], h[1], h[2], h[3]})
#define PV_D0(d0) do { s16x4 l0, l1, l2, l3, h0, h1, h2, h3; constexpr int b_ = VB * SHM_V + v_rd_off(d0, 0, 0);   \
        TRRD(l0, b_); TRRD(h0, b_ + 2048); TRRD(l1, b_ + 4096); TRRD(h1, b_ + 6144); TRRD(l2, b_ + 8192); TRRD(h2, b_ + 10240); TRRD(l3, b_ + 12288); TRRD(h3, b_ + 14336); \
        asm volatile("s_waitcnt lgkmcnt(0)" ::: "memory"); SBAR();                                                   \
        o[d0] = __builtin_amdgcn_mfma_f32_32x32x16_f16(pa0, MKB(l0, h0), o[d0], 0, 0, 0);   \
        o[d0] = __builtin_amdgcn_mfma_f32_32x32x16_f16(pa1, MKB(l1, h1), o[d0], 0, 0, 0);   \
        o[d0] = __builtin_amdgcn_mfma_f32_32x32x16_f16(pa2, MKB(l2, h2), o[d0], 0, 0, 0);   \
        o[d0] = __builtin_amdgcn_mfma_f32_32x32x16_f16(pa3, MKB(l3, h3), o[d0], 0, 0, 0);   \
        if ((d0) == 3) asm volatile("s_nop 15\n\ts_nop 15" :: "v"(l2), "v"(h2), "v"(l3), "v"(h3), "v"(pa0), "v"(pa1), "v"(pa2), "v"(pa3)); } while (0)
    PV_D0(0); PV_D0(1); PV_D0(2); PV_D0(3);
#undef PV_D0
#undef MKB
#undef TRRD
}

struct BlockRef { const half_t* Q; const half_t* K; const half_t* V; const float* KM; const half_t* ZA; half_t* O; int P0; };
struct Seam { h8 qr[8]; h8 st_v0, st_v1, st_k0, st_k1; };
#define HEADRS(p) pg8::mkrsrc((p), (size_t)SEQ * D * 2)
#define BLD8(rs, voff, soff) __builtin_bit_cast(h8, pg8::bld128((rs), (voff), (unsigned)(soff)))
#define VMW() asm volatile("s_waitcnt vmcnt(0)" ::: "memory")
#define VMWN(n) asm volatile("s_waitcnt vmcnt(%0)" :: "i"(n) : "memory")
#define SLOAD_H(Kp, Vp, k0) do { const pg8::rsrc_t rk_ = HEADRS(Kp), rv_ = HEADRS(Vp);                                           \
                         S.st_v0 = BLD8(rv_, lkv, (k0) * (D * 2)); S.st_v1 = BLD8(rv_, lkv, ((k0) + 32) * (D * 2));              \
                         S.st_k0 = BLD8(rk_, lkv, (k0) * (D * 2)); S.st_k1 = BLD8(rk_, lkv, ((k0) + 32) * (D * 2)); } while (0)
#define SWRITE_HK(bf) do { *(h8*)(K_lds + (bf) * SHM_K + kws) = S.st_k0; *(h8*)(K_lds + (bf) * SHM_K + kws + 32 * 256) = S.st_k1; } while (0)
#define SWRITE_HV(bf) do { *(h8*)(V_lds + (bf) * SHM_V + vst0) = S.st_v0; *(h8*)(V_lds + (bf) * SHM_V + vst1) = S.st_v1; } while (0)
#define SWRITE_H(bf) do { SWRITE_HV(bf); SWRITE_HK(bf); } while (0)
__device__ __forceinline__ void prime(const BlockRef& cur, char* lds, Seam& S, int tid) {
    const int wid = __builtin_amdgcn_readfirstlane(tid >> 6), lane = tid & 63, r32 = lane & 31, hi = lane >> 5;
    const int sr = tid >> 4, sc = (tid & 15) * 8, kws = KSWZ(sr, sc * 2); char* K_lds = lds + 2 * SHM_V;
    const unsigned lkv = (unsigned)(sr * D + sc) * 2u, lq = (unsigned)((wid * QBLK + r32) * D + hi * 8) * 2u;
    { const pg8::rsrc_t rq_ = pg8::mkrsrc(cur.Q, (size_t)QB * D * 2);
#pragma unroll
      for (int d0 = 0; d0 < 8; ++d0) S.qr[d0] = BLD8(rq_, lq, d0 * 32); }
    SLOAD_H(cur.K, cur.V, 0); VMW(); SWRITE_HK(0);
    __syncthreads();
}
__device__ __forceinline__ unsigned moba_select(const float* KM, const h8* qr, int own, int r32, int hi) {
    f32x16 g = f32x16{}; asm volatile("" : "+v"(g));
    const int jb = r32 & 7; const bool lo_part = (r32 & 8) != 0, live = r32 < 16;
#pragma unroll
    for (int d0 = 0; d0 < 8; ++d0) {
        h8 a = {0, 0, 0, 0, 0, 0, 0, 0};
        if (live) { const float* p = KM + jb * D + d0 * 16 + hi * 8;
            const f32x4 x0 = *(const f32x4*)p + *(const f32x4*)(p + pg8::KMEAN_PART), x1 = *(const f32x4*)(p + 4) + *(const f32x4*)(p + 4 + pg8::KMEAN_PART);
#pragma unroll
            for (int e = 0; e < 4; ++e) { const half_t h0 = (half_t)x0[e], h1 = (half_t)x1[e]; a[e] = lo_part ? (half_t)(x0[e] - (float)h0) : h0; a[4 + e] = lo_part ? (half_t)(x1[e] - (float)h1) : h1; } }
        g = __builtin_amdgcn_mfma_f32_32x32x16_f16(a, qr[d0], g, 0, 0, 0);
        asm volatile("s_nop 7" :: "v"(a));
    }
    float gt[8];
#pragma unroll
    for (int j = 0; j < 4; ++j) { const float x = g[j] + g[4 + j];
        auto rr = __builtin_amdgcn_permlane32_swap(__float_as_uint(x), __float_as_uint(x), false, false);
        gt[j] = __uint_as_float(rr[0]); gt[4 + j] = __uint_as_float(rr[1]); }
    unsigned sel = 1u << own;
#pragma unroll
    for (int j = 0; j < 7; ++j) { int rank = 0;
#pragma unroll
        for (int k = 0; k < 7; ++k) if (k != j) rank += (k < own && (gt[k] > gt[j] || (gt[k] == gt[j] && k < j))) ? 1 : 0;
        if (j < own && rank < TOPK) sel |= 1u << j; }
    return sel;
}
__device__ __forceinline__ void block(const BlockRef& cur, const BlockRef& nxt, char* lds, Seam& S, int tid) {
    const int wid = __builtin_amdgcn_readfirstlane(tid >> 6), lane = tid & 63, r32 = lane & 31, hi = lane >> 5;
    const int own = cur.P0 / QB, NT = 4 * (own + 1);
    const int qlo = cur.P0 + wid * QBLK, qm = qlo + r32 - 4 * hi;
    char* V_lds = lds; char* K_lds = lds + 2 * SHM_V;
    float* ws = (float*)(lds + 2 * SHM_V + 2 * SHM_K) + wid * 64; float* li_l = ws, * al_l = ws + 32;
    float m_reg = -1e30f, l_reg = 0; f32x16 o[4] = {};
    const int sr = tid >> 4, sc = (tid & 15) * 8, vst0 = v_st(sr, sc), vst1 = v_st(32 + sr, sc), kws = KSWZ(sr, sc * 2);
    const int vb0 = (int)(uintptr_t)V_lds + v_rd_base(lane);
    const unsigned lkv = (unsigned)(sr * D + sc) * 2u, lq = (unsigned)((wid * QBLK + r32) * D + hi * 8) * 2u;
    const half_t* Kh = cur.K; const half_t* Vh = cur.V;
    const unsigned selm = moba_select(cur.KM, S.qr, own, r32, hi);
#define RESC(a) do { if (__any((a) < 1.f)) { if (hi == 0) al_l[r32] = (a); asm volatile("s_waitcnt lgkmcnt(0)" ::: "memory");              \
                     for (int d_ = 0; d_ < 4; ++d_) for (int r = 0; r < 16; ++r) o[d_][r] *= al_l[crow(r, hi)]; } } while (0)
#define KBASE(t) ((t) * KVBLK)
#define SELT(t) (((selm >> ((t) >> 2)) & 1u) != 0u)
#define MASKT(P0_, P1_, t) do { const int kb_ = KBASE(t); if (kb_ + KVBLK - 1 > qlo) mask_tile(P0_, P1_, qm - kb_); } while (0)
    constexpr int NQL = 8;
#define SEAM_K0() do { VMWN(NQL); SWRITE_HK(0); SBAR(); } while (0)
    f32x16 pA0, pA1, pB0, pB1; float mnA, mnB, alA, alB; h8 pa0, pa1, pa2, pa3;
    SWRITE_HV(0); SBAR();
    if (NT > 1) { SLOAD_H(Kh, Vh, KBASE(1)); }
    SBAR(); qkt<0>(pA0, pA1, K_lds, r32, hi, S.qr);
    MASKT(pA0, pA1, 0); partialSM(pA0, pA1, m_reg, mnA, alA, SELT(0));
    if (NT > 1) { VMW(); SWRITE_H(1); }
    __syncthreads();
#define HALF_STEP(PX0, PX1, mnX, alX, PY0, PY1, alY, t, KB, VB, SB) do {                                                      \
        SBAR(); qkt<KB>(PX0, PX1, K_lds, r32, hi, S.qr);                                                                      \
        finishSM(PY0, PY1, alY, l_reg, pa0, pa1, pa2, pa3); SBAR();                                                           \
        if ((t) + 1 < NT) { SLOAD_H(Kh, Vh, KBASE((t) + 1)); SBAR(); }                                                        \
        pv_tile<VB>(o, vb0, pa0, pa1, pa2, pa3); MASKT(PX0, PX1, (t)); partialSM(PX0, PX1, m_reg, mnX, alX, SELT(t));        \
        __syncthreads();                                                                                                      \
        if ((t) + 1 < NT) { VMW(); SWRITE_H(SB); }                                                                            \
        RESC(alX); __syncthreads(); } while (0)
    for (int t = 1; t + 1 < NT; t += 2) {
        HALF_STEP(pB0, pB1, mnB, alB, pA0, pA1, alA, t, 1, 0, 0);
        HALF_STEP(pA0, pA1, mnA, alA, pB0, pB1, alB, t + 1, 0, 1, 1);
    }
    SBAR(); qkt<1>(pB0, pB1, K_lds, r32, hi, S.qr); SBAR();
    SLOAD_H(nxt.K, nxt.V, 0); SBAR();
    { const pg8::rsrc_t rq_ = pg8::mkrsrc(nxt.Q, (size_t)QB * D * 2);
#pragma unroll
      for (int d0 = 0; d0 < 8; ++d0) S.qr[d0] = BLD8(rq_, lq, d0 * 32); }
    SBAR();
    finishSM(pA0, pA1, alA, l_reg, pa0, pa1, pa2, pa3); SBAR();
    pv_tile<0>(o, vb0, pa0, pa1, pa2, pa3);
    MASKT(pB0, pB1, NT - 1); partialSM(pB0, pB1, m_reg, mnB, alB, true); __syncthreads(); RESC(alB);
    finishSM(pB0, pB1, alB, l_reg, pa0, pa1, pa2, pa3); SBAR(); pv_tile<1>(o, vb0, pa0, pa1, pa2, pa3);
    SBAR(); SEAM_K0();
    if (hi == 0) li_l[r32] = l_reg; asm volatile("s_waitcnt lgkmcnt(0)" ::: "memory");
    float rli[16];
#pragma unroll
    for (int r = 0; r < 16; ++r) rli[r] = __builtin_amdgcn_rcpf(li_l[crow(r, hi)]);
    {
        const pg8::rsrc_t rz = pg8::mkrsrc(cur.ZA, (size_t)QB * ATT_W * 2), ro = pg8::mkrsrc(cur.O, (size_t)QB * BR_K * 2);
        const unsigned vz = (unsigned)((wid * QBLK + (lane >> 4)) * ATT_W + (lane & 15) * 8) * 2u, vo = (unsigned)((wid * QBLK + (lane >> 4)) * BR_K + (lane & 15) * 8) * 2u;
        u32x4 z[8];
#pragma unroll
        for (int i = 0; i < 8; ++i) z[i] = pg8::bld128(rz, vz, (unsigned)(i * 4 * ATT_W) * 2u);
        LAS unsigned char* ost = (LAS unsigned char*)(uintptr_t)(unsigned)(uintptr_t)(lds + OST_OFF) + wid * OST_WAVE;
        LAS unsigned char* ow = ost + 4 * hi * OST_ROW + r32 * 2;
#pragma unroll
        for (int r = 0; r < 16; ++r) { const int rowc = (r & 3) + 8 * (r >> 2);
#pragma unroll
            for (int d0 = 0; d0 < 4; ++d0) *(LAS half_t*)(ow + rowc * OST_ROW + d0 * 64) = (half_t)(o[d0][r] * rli[r]); }
        asm volatile("s_waitcnt lgkmcnt(0)" ::: "memory");
        const LAS unsigned char* orp = ost + (lane >> 4) * OST_ROW + (lane & 15) * 16;
#pragma unroll
        for (int i = 0; i < 8; ++i) { f32x4 a0, a1, z0, z1; unpk8h(*(const LAS u32x4*)(orp + i * 4 * OST_ROW), a0, a1); unpk8h(z[i], z0, z1);
            pg8::bst128(pk8h(a0 * z0, a1 * z1), ro, vo, (unsigned)(i * 4 * BR_K) * 2u); }
    }
    __syncthreads();
#undef RESC
#undef KBASE
#undef SELT
#undef MASKT
#undef SEAM_K0
#undef HALF_STEP
}
#undef HEADRS
#undef BLD8
#undef VMW
#undef VMWN
#undef SLOAD_H
#undef SWRITE_HK
#undef SWRITE_HV
#undef SWRITE_H

__device__ __forceinline__ BlockRef make_ref(int L, int pass, const unsigned char* ws) {
    const int bh = L >> 2, x = L & 3, qb = pass ? (NBLK - 1 - x) : x, b = bh / NH, h = bh % NH;
    BlockRef r; const size_t hb = (size_t)bh * SEQ * D;
    r.Q = (const half_t*)(ws + WS_Q) + hb + (size_t)qb * QB * D; r.K = (const half_t*)(ws + WS_K) + hb; r.V = (const half_t*)(ws + WS_V) + hb;
    r.KM = (const float*)(ws + WS_KMEAN) + (size_t)bh * NBLK * D;
    const size_t m0 = (size_t)b * SEQ + (size_t)qb * QB;
    r.ZA = (const half_t*)(ws + WS_ZA) + m0 * ATT_W + h * D; r.O = (half_t*)(ws + WS_OSA) + m0 * BR_K + SSM_W + h * D; r.P0 = qb * QB;
    return r;
}
__device__ __forceinline__ void phase(char* lds, const unsigned char* ws, int vcu, int G) {
    int tid_ = threadIdx.x; asm volatile("" : "+v"(tid_));
    const int total = BATCH * NH * 4;
#ifdef EXP_ATT_SCATTER
    int L = blockIdx.x; if (L >= total) return;
#else
    int L = vcu; if (L >= total) return;
#endif
    int pass = 0; BlockRef cur = make_ref(L, 0, ws);
    Seam S; prime(cur, lds, S, tid_);
    for (;;) {
        const bool more_pass = pass == 0, more_item = L + G < total, last = !more_pass && !more_item;
        int passn = pass + 1, Ln = L; if (!more_pass) { passn = 0; Ln = more_item ? L + G : L; }
        const BlockRef nxt = last ? cur : make_ref(Ln, passn, ws);
        block(cur, nxt, lds, S, tid_);
        if (last) break;
        cur = nxt; pass = passn; L = Ln;
    }
}
}
static_assert(attn::LDS_BYTES_ATT <= RING_BYTES && s5::LDS_BYTES_S5 <= RING_BYTES && pg8::STAGE_BYTES <= RING_BYTES, "phase scratch must stay below the LDS control words");

struct Frame {
    LAS unsigned char* lds; volatile LAS unsigned* MISC; gu32* ctl;
    int tid, lane, wave, vcu, G;
};

__device__ __forceinline__ float wave_sum(float v) {
#pragma unroll
    for (int o = 1; o < 64; o <<= 1) v += __shfl_xor(v, o);
    return v;
}
__host__ __device__ __forceinline__ int bt_slot(int c, bool natural) { return natural ? c : (16 * ((c >> 2) & 1) + 4 * (c >> 3) + (c & 3)); }

__device__ __forceinline__ void p0_transpose_item(const float* W, int N, half_t* WT, int ldk, int koff, bool rope_cols, LAS float* scr, int item, int lane) {
    const int nblk = N / 32, kb = item / nblk, nb = item % nblk, k0 = 64 * kb, n0 = 32 * nb;
    f32x4 t[8];
#pragma unroll
    for (int i = 0; i < 8; ++i) t[i] = *(const f32x4*)(W + (size_t)(k0 + 8 * i + (lane >> 3)) * N + n0 + 4 * (lane & 7));
#pragma unroll
    for (int i = 0; i < 8; ++i) { LAS float* d = scr + (8 * i + (lane >> 3)) * 33 + 4 * (lane & 7); d[0] = t[i].x; d[1] = t[i].y; d[2] = t[i].z; d[3] = t[i].w; }
    LDS_WAIT(); asm volatile("" ::: "memory");
    const bool natural = rope_cols && n0 >= 2048 && n0 < 6144 && (n0 & 127) == 0;
    const pg8::rsrc_t rw = pg8::mkrsrc(WT, (size_t)N * ldk * 2);
    const int c = lane & 7;
#pragma unroll
    for (int j = 0; j < 4; ++j) { const int n = (lane >> 3) + 8 * j; const LAS float* s = scr + (8 * c) * 33 + n;
        u32x4 o; o.x = pk2h(s[0 * 33], s[1 * 33]); o.y = pk2h(s[2 * 33], s[3 * 33]); o.z = pk2h(s[4 * 33], s[5 * 33]); o.w = pk2h(s[6 * 33], s[7 * 33]);
        pg8::bst128(o, rw, (unsigned)(((size_t)(n0 + bt_slot(n, natural)) * ldk + koff + k0 + 8 * c) * 2), 0u); }
    LDS_WAIT(); asm volatile("" ::: "memory");
}

struct Args { const float* in[17]; float* out; unsigned char* ws; int ph_lo, ph_hi; };

__device__ __forceinline__ void norm_row_to_h(const float* xrow, const float* g, half_t* orow, int lane) {
    f32x4 v[8]; float s = 0.f;
#pragma unroll
    for (int j = 0; j < 8; ++j) { v[j] = *(const f32x4*)(xrow + 4 * lane + 256 * j); s += (v[j].x * v[j].x + v[j].y * v[j].y) + (v[j].z * v[j].z + v[j].w * v[j].w); }
    const float r = rsqrtf(wave_sum(s) * (1.f / D_MODEL) + EPS);
#pragma unroll
    for (int j = 0; j < 8; ++j) { const f32x4 gg = *(const f32x4*)(g + 4 * lane + 256 * j);
        u32x2 o = {pk2h(v[j].x * r * gg.x, v[j].y * r * gg.y), pk2h(v[j].z * r * gg.z, v[j].w * r * gg.w)};
        __hip_atomic_store((unsigned long long*)(orow + 4 * lane + 256 * j), __builtin_bit_cast(unsigned long long, o), RLX_AGENT); }
}
__device__ __forceinline__ void resnorm_row(const float* xi, const half_t* orow, const float* gpost, float* xo, const float* gpre, half_t* xn, int lane) {
    f32x4 v[8]; float s = 0.f;
#pragma unroll
    for (int j = 0; j < 8; ++j) { const h4 hv = *(const h4*)(orow + 4 * lane + 256 * j); v[j] = (f32x4){(float)hv[0], (float)hv[1], (float)hv[2], (float)hv[3]}; s += (v[j].x * v[j].x + v[j].y * v[j].y) + (v[j].z * v[j].z + v[j].w * v[j].w); }
    const float r = rsqrtf(wave_sum(s) * (1.f / D_MODEL) + EPS); float s2 = 0.f;
#pragma unroll
    for (int j = 0; j < 8; ++j) { const f32x4 gg = *(const f32x4*)(gpost + 4 * lane + 256 * j), xx = *(const f32x4*)(xi + 4 * lane + 256 * j);
        v[j] = xx + v[j] * r * gg; pg8::bst128(__builtin_bit_cast(u32x4, v[j]), pg8::mkrsrc(xo, (size_t)D_MODEL * 4), (unsigned)(4 * lane + 256 * j) * 4u, 0u); s2 += (v[j].x * v[j].x + v[j].y * v[j].y) + (v[j].z * v[j].z + v[j].w * v[j].w); }
    if (xn) { const float r2 = rsqrtf(wave_sum(s2) * (1.f / D_MODEL) + EPS);
#pragma unroll
        for (int j = 0; j < 8; ++j) { const f32x4 gg = *(const f32x4*)(gpre + 4 * lane + 256 * j);
            u32x2 o = {pk2h(v[j].x * r2 * gg.x, v[j].y * r2 * gg.y), pk2h(v[j].z * r2 * gg.z, v[j].w * r2 * gg.w)};
            __hip_atomic_store((unsigned long long*)(xn + 4 * lane + 256 * j), __builtin_bit_cast(unsigned long long, o), RLX_AGENT); } }
}

__device__ __forceinline__ void p0_prologue(Frame& F0, const Args& a) {
    unsigned char* ws = a.ws;
    Frame F = F0; { int t_ = threadIdx.x; asm volatile("" : "+v"(t_)); F.tid = t_; F.lane = t_ & 63; F.wave = __builtin_amdgcn_readfirstlane(t_ >> 6); }
    LAS float* scr = (LAS float*)(F.lds + RING_OFF + F.wave * 16384);
    const int gw = F.vcu * NWAVES + F.wave, NGW = F.G * NWAVES;
    constexpr int I_IN = (D_MODEL / 64) * (IN_W / 32), I_GLU = (SSM_W / 64) * (SSM_W / 32), I_BS = (SSM_W / 64) * (D_MODEL / 32), I_BA = (ATT_W / 64) * (D_MODEL / 32), I_OUT = (D_MODEL / 64) * (D_MODEL / 32);
    constexpr int I_LAYER = I_IN + I_GLU + I_BS + I_BA + I_OUT;
    for (int it = gw; it < DEPTH * I_LAYER; it += NGW) {
        const int l = it / I_LAYER; int r = it % I_LAYER;
        if (r < I_IN) { p0_transpose_item(a.in[3] + (size_t)l * D_MODEL * IN_W, IN_W, (half_t*)(ws + WS_WIN + l * WIN_STRIDE), D_MODEL, 0, true, scr, r, F.lane); continue; } r -= I_IN;
        if (r < I_GLU) { p0_transpose_item(a.in[12] + (size_t)l * SSM_W * SSM_W, SSM_W, (half_t*)(ws + WS_WGLU + l * WGLU_STRIDE), SSM_W, 0, false, scr, r, F.lane); continue; } r -= I_GLU;
        if (r < I_BS) { p0_transpose_item(a.in[14] + (size_t)l * SSM_W * D_MODEL, D_MODEL, (half_t*)(ws + WS_WBR + l * WBR_STRIDE), BR_K, 0, false, scr, r, F.lane); continue; } r -= I_BS;
        if (r < I_BA) { p0_transpose_item(a.in[15] + (size_t)l * ATT_W * D_MODEL, D_MODEL, (half_t*)(ws + WS_WBR + l * WBR_STRIDE), BR_K, SSM_W, false, scr, r, F.lane); continue; } r -= I_BA;
        p0_transpose_item(a.in[16] + (size_t)l * D_MODEL * D_MODEL, D_MODEL, (half_t*)(ws + WS_WOUT + l * WOUT_STRIDE), D_MODEL, 0, false, scr, r, F.lane);
    }
    const int gt = F.vcu * (NWAVES * 64) + F.tid, NGT = F.G * NWAVES * 64;
    for (int i = gt; i < SEQ * ROT_H; i += NGT) { const int t = i / ROT_H, j = i % ROT_H;
        const float inv_freq = powf(500000.0f, -(float)(2 * j) / (float)ROT), ang = (float)t * inv_freq;
        float* rp = (float*)(ws + WS_ROPE) + (size_t)t * 32; __hip_atomic_store(rp + j, cosf(ang), RLX_AGENT); __hip_atomic_store(rp + 16 + j, sinf(ang), RLX_AGENT); }
    for (int i = gt; i < DEPTH * SSM_G * SSM_P; i += NGT) { const int l = i / (SSM_G * SSM_P), g = (i / SSM_P) % SSM_G, p = i % SSM_P;
        const float lr = a.in[4][i], li = a.in[5][i], ldt = a.in[6][l * SSM_G + g], dt = expf(ldt);
        const float mag = expf(lr * dt), are = mag * cosf(li * dt), aim = mag * sinf(li * dt);
        const float den = lr * lr + li * li, nr = are - 1.f, ni = aim, fre = (nr * lr + ni * li) / den, fim = (ni * lr - nr * li) / den;
        const float sc = exp2f(rintf(-ldt * 1.4426950408889634f));
        unsigned char* s5 = ws + WS_S5 + l * S5_STRIDE;
        float pr = are, pi = aim;
#pragma unroll
        for (int q = 0; q < 7; ++q) { const float nr2 = pr * pr - pi * pi, ni2 = 2.f * pr * pi; pr = nr2; pi = ni2; }
        pg8::bst128(__builtin_bit_cast(u32x4, (f32x4){are, aim, pr, pi}), pg8::mkrsrc(s5 + S5_A, (size_t)SSM_G * SSM_P * 16), (unsigned)(g * SSM_P + p) * 16u, 0u);
        half_t* bb = (half_t*)(s5 + S5_BB) + (size_t)g * 128 * 16; half_t* cm = (half_t*)(s5 + S5_CM) + (size_t)g * 16 * 128;
        const float* bre = a.in[7] + (size_t)i * SSM_GC; const float* bim = a.in[8] + (size_t)i * SSM_GC;
        unsigned bbr[8], bbi[8];
#pragma unroll
        for (int c = 0; c < SSM_GC; c += 2) { const float br0 = bre[c], bi0 = bim[c], br1 = bre[c + 1], bi1 = bim[c + 1];
            bbr[c >> 1] = pk2h((fre * br0 - fim * bi0) * sc, (fre * br1 - fim * bi1) * sc); bbi[c >> 1] = pk2h((fre * bi0 + fim * br0) * sc, (fre * bi1 + fim * br1) * sc); }
        { const pg8::rsrc_t rb = pg8::mkrsrc(bb, (size_t)128 * 16 * 2);
          pg8::bst128((u32x4){bbr[0], bbr[1], bbr[2], bbr[3]}, rb, (unsigned)p * 32u, 0u); pg8::bst128((u32x4){bbr[4], bbr[5], bbr[6], bbr[7]}, rb, (unsigned)p * 32u + 16u, 0u);
          pg8::bst128((u32x4){bbi[0], bbi[1], bbi[2], bbi[3]}, rb, (unsigned)(64 + p) * 32u, 0u); pg8::bst128((u32x4){bbi[4], bbi[5], bbi[6], bbi[7]}, rb, (unsigned)(64 + p) * 32u + 16u, 0u); }
#pragma unroll
        for (int c = 0; c < SSM_GC; ++c) { const size_t ci = ((size_t)(l * SSM_G + g) * SSM_GC + c) * SSM_P + p;
            __hip_atomic_store((unsigned*)(cm + (size_t)c * 128 + 2 * p), pk2h(a.in[9][ci], -a.in[10][ci]), RLX_AGENT); }
    }
    for (int m = gw; m < M; m += NGW) norm_row_to_h(a.in[0] + (size_t)m * D_MODEL, a.in[1], (half_t*)(ws + WS_XN) + (size_t)m * D_MODEL, F.lane);
}

#ifndef REPEAT_MASK
#define REPEAT_MASK 0
#endif
#ifndef S5_USRC
#define S5_USRC WS_U
#endif
constexpr int PH_PER_LAYER = 6, N_PHASES = 1 + DEPTH * PH_PER_LAYER;
__global__ void __launch_bounds__(NWAVES * 64, 2) mk_fwd(Args args) {
    extern __shared__ __attribute__((aligned(16))) unsigned char lds[];
    Frame F;
    F.lds = (LAS unsigned char*)lds; F.MISC = (volatile LAS unsigned*)(F.lds + MISC_OFF);
    F.tid = 0; F.lane = 0; F.wave = 0;
    F.G = gridDim.x; { const int bx = blockIdx.x; F.vcu = (F.G % 8 == 0) ? (bx % 8) * (F.G / 8) + bx / 8 : bx; }
    unsigned char* ws = args.ws;
    F.ctl = (gu32*)(ws + WS_CTL);
#ifdef EXP_ZERO_LDS
    for (int u = threadIdx.x; u < LDSCTL_OFF / 4; u += NWAVES * 64) ((LAS unsigned*)(F.lds))[u] = 0u;
#endif
    for (int u = threadIdx.x; u < (LDS_BYTES - LDSCTL_OFF) / 4; u += NWAVES * 64) ((LAS unsigned*)(F.lds + LDSCTL_OFF))[u] = 0u;
    __syncthreads();
    XcdBarrier bar = xcd_barrier_post((unsigned*)(F.ctl + CW_BAR), F.MISC + 8);
    const int lo = args.ph_lo, hi = args.ph_hi;
#define IN(k) (lo <= (k) && (k) < hi)
#ifdef EXP_SIMPLE_BAR
#define SEAM(k) do { if (IN(k) && IN((k) + 1)) { asm volatile("s_waitcnt vmcnt(0)" ::: "memory"); __syncthreads(); \
      if (threadIdx.x == 0) { unsigned* c_ = (unsigned*)(F.ctl + 2048); const unsigned ep_ = F.MISC[12] + 1u; F.MISC[12] = ep_; \
          __builtin_amdgcn_fence(__ATOMIC_RELEASE, "agent"); asm volatile("s_waitcnt vmcnt(0)" ::: "memory"); \
          __hip_atomic_fetch_add(c_, 1u, __ATOMIC_RELAXED, __HIP_MEMORY_SCOPE_AGENT); \
          while (__hip_atomic_load(c_, __ATOMIC_RELAXED, __HIP_MEMORY_SCOPE_AGENT) < ep_ * gridDim.x) __builtin_amdgcn_s_sleep(2); \
          __builtin_amdgcn_fence(__ATOMIC_ACQUIRE, "agent"); asm volatile("s_waitcnt vmcnt(0)" ::: "memory"); } \
      __syncthreads(); } } while (0)
#else
#define SEAM(k) do { if (IN(k) && IN((k) + 1)) { xcd_barrier(bar); SEAM_DELAY(); } } while (0)
#endif
#ifdef EXP_DELAY
#define SEAM_DELAY() do { __builtin_amdgcn_s_sleep(127); __builtin_amdgcn_s_sleep(127); __builtin_amdgcn_s_sleep(127); } while (0)
#else
#define SEAM_DELAY() do {} while (0)
#endif
#ifdef EXP_SELF_POISON
    if (IN(0)) { const size_t gt_ = (size_t)blockIdx.x * (NWAVES * 64) + threadIdx.x, ngt_ = (size_t)gridDim.x * NWAVES * 64; u32x4 zz = {0u, 0u, 0u, 0u};
        for (size_t o = gt_ * 16; o < (size_t)(576 - 160) * MiB; o += ngt_ * 16) *(GAS u32x4*)(ws + WS_XN + o) = zz;
        for (size_t o = gt_ * 16; o < (size_t)3 * MiB; o += ngt_ * 16) *(GAS u32x4*)(ws + WS_ROPE + o) = zz;
        xcd_barrier(bar); }
#endif
    if (IN(0)) { p0_prologue(F, args); }
#if REPEAT_MASK & 64
    xcd_barrier(bar); p0_prologue(F, args);
#endif
    SEAM(0);
#pragma unroll 1
    for (int l = 0; l < DEPTH; ++l) {
        const int pb = 1 + l * PH_PER_LAYER;
        half_t* XN = (half_t*)(ws + WS_XN);
        if (IN(pb + 0)) {
            pg8::Gemm g{XN, (const half_t*)(ws + WS_WIN + l * WIN_STRIDE), M, IN_W, D_MODEL}; pg8::StaticOrder S; S.init(M, IN_W, F.G, (int)blockIdx.x);
            pg8::EpiIn E{ws, (float*)(ws + WS_KMEAN), (const float*)(ws + WS_ROPE)};
            pg8::gemm_phase<pg8::EpiIn, pg8::StaticOrder, true, true>(F.lds + RING_OFF, g, S, E);
        }
#if REPEAT_MASK & 1
        xcd_barrier(bar);
        if (IN(pb + 0)) {
            pg8::Gemm g{XN, (const half_t*)(ws + WS_WIN + l * WIN_STRIDE), M, IN_W, D_MODEL}; pg8::StaticOrder S; S.init(M, IN_W, F.G, (int)blockIdx.x);
            pg8::EpiIn E{ws, (float*)(ws + WS_KMEAN), (const float*)(ws + WS_ROPE)};
            pg8::gemm_phase<pg8::EpiIn, pg8::StaticOrder, true, true>(F.lds + RING_OFF, g, S, E);
        }
#endif
        SEAM(pb + 0);
        if (IN(pb + 1)) {
#ifdef EXP_S5_LOOP2
            int nrep_ = 2; asm volatile("" : "+s"(nrep_));
            for (int rep_ = 0; rep_ < nrep_; ++rep_)
#endif
#ifdef EXP_S5_SCATTER
            for (int u = blockIdx.x; u < BATCH * SSM_G; u += F.G) {
#else
            for (int u = F.vcu; u < BATCH * SSM_G; u += F.G) {
#endif
                s5::unit(F.lds + RING_OFF, u / SSM_G, u % SSM_G, (const half_t*)(ws + S5_USRC), (half_t*)(ws + WS_YS), ws + WS_S5 + l * S5_STRIDE, args.in[11] + l * SSM_W, args.in[6] + l * SSM_G);
            }
            attn::phase((char*)lds + RING_OFF, ws, F.vcu, F.G);
        }
#if REPEAT_MASK & 2
        xcd_barrier(bar);
        if (IN(pb + 1)) { for (int u = F.vcu; u < BATCH * SSM_G; u += F.G)
                s5::unit(F.lds + RING_OFF, u / SSM_G, u % SSM_G, (const half_t*)(ws + S5_USRC), (half_t*)(ws + WS_YS), ws + WS_S5 + l * S5_STRIDE, args.in[11] + l * SSM_W, args.in[6] + l * SSM_G); }
#endif
#if REPEAT_MASK & 32
        xcd_barrier(bar);
        if (IN(pb + 1)) { attn::phase((char*)lds + RING_OFF, ws, F.vcu, F.G); }
#endif
        SEAM(pb + 1);
        if (IN(pb + 2)) {
            pg8::Gemm g{(const half_t*)(ws + WS_YS), (const half_t*)(ws + WS_WGLU + l * WGLU_STRIDE), M, SSM_W, SSM_W}; pg8::StaticOrder S; S.init(M, SSM_W, F.G, (int)blockIdx.x);
            pg8::EpiGlu E{(const half_t*)(ws + WS_YS), (const half_t*)(ws + WS_ZS), args.in[13] + l * SSM_W, (half_t*)(ws + WS_OSA)};
            pg8::gemm_phase<pg8::EpiGlu, pg8::StaticOrder, true, true>(F.lds + RING_OFF, g, S, E);
        }
#if REPEAT_MASK & 4
        xcd_barrier(bar);
        if (IN(pb + 2)) {
            pg8::Gemm g{(const half_t*)(ws + WS_YS), (const half_t*)(ws + WS_WGLU + l * WGLU_STRIDE), M, SSM_W, SSM_W}; pg8::StaticOrder S; S.init(M, SSM_W, F.G, (int)blockIdx.x);
            pg8::EpiGlu E{(const half_t*)(ws + WS_YS), (const half_t*)(ws + WS_ZS), args.in[13] + l * SSM_W, (half_t*)(ws + WS_OSA)};
            pg8::gemm_phase<pg8::EpiGlu, pg8::StaticOrder, true, true>(F.lds + RING_OFF, g, S, E);
        }
#endif
        SEAM(pb + 2);
        if (IN(pb + 3)) {
            pg8::Gemm g{(const half_t*)(ws + WS_OSA), (const half_t*)(ws + WS_WBR + l * WBR_STRIDE), M, D_MODEL, BR_K}; pg8::StaticOrder S; S.init(M, D_MODEL, F.G, (int)blockIdx.x);
            pg8::EpiMerge E{(const half_t*)(ws + WS_GS), (const half_t*)(ws + WS_GA), (half_t*)(ws + WS_MG)};
            pg8::gemm_phase<pg8::EpiMerge, pg8::StaticOrder, true, true>(F.lds + RING_OFF, g, S, E);
        }
#if REPEAT_MASK & 8
        xcd_barrier(bar);
        if (IN(pb + 3)) {
            pg8::Gemm g{(const half_t*)(ws + WS_OSA), (const half_t*)(ws + WS_WBR + l * WBR_STRIDE), M, D_MODEL, BR_K}; pg8::StaticOrder S; S.init(M, D_MODEL, F.G, (int)blockIdx.x);
            pg8::EpiMerge E{(const half_t*)(ws + WS_GS), (const half_t*)(ws + WS_GA), (half_t*)(ws + WS_MG)};
            pg8::gemm_phase<pg8::EpiMerge, pg8::StaticOrder, true, true>(F.lds + RING_OFF, g, S, E);
        }
#endif
        SEAM(pb + 3);
        if (IN(pb + 4)) {
            pg8::Gemm g{(const half_t*)(ws + WS_MG), (const half_t*)(ws + WS_WOUT + l * WOUT_STRIDE), M, D_MODEL, D_MODEL}; pg8::StaticOrder S; S.init(M, D_MODEL, F.G, (int)blockIdx.x);
            pg8::EpiOut E{(half_t*)(ws + WS_OUT)};
            pg8::gemm_phase<pg8::EpiOut, pg8::StaticOrder, true, true>(F.lds + RING_OFF, g, S, E);
        }
#if REPEAT_MASK & 16
        xcd_barrier(bar);
        if (IN(pb + 4)) {
            pg8::Gemm g{(const half_t*)(ws + WS_MG), (const half_t*)(ws + WS_WOUT + l * WOUT_STRIDE), M, D_MODEL, D_MODEL}; pg8::StaticOrder S; S.init(M, D_MODEL, F.G, (int)blockIdx.x);
            pg8::EpiOut E{(half_t*)(ws + WS_OUT)};
            pg8::gemm_phase<pg8::EpiOut, pg8::StaticOrder, true, true>(F.lds + RING_OFF, g, S, E);
        }
#endif
        SEAM(pb + 4);
        if (IN(pb + 5)) {
            int t_ = threadIdx.x; asm volatile("" : "+v"(t_)); const int lane_ = t_ & 63, wave_ = __builtin_amdgcn_readfirstlane(t_ >> 6);
            const int gw = F.vcu * NWAVES + wave_, NGW = F.G * NWAVES;
            const float* xi = l == 0 ? args.in[0] : args.out;
            for (int m = gw; m < M; m += NGW)
                resnorm_row(xi + (size_t)m * D_MODEL, (const half_t*)(ws + WS_OUT) + (size_t)m * D_MODEL, args.in[2] + l * D_MODEL, args.out + (size_t)m * D_MODEL,
                            args.in[1] + (l + 1 < DEPTH ? l + 1 : l) * D_MODEL, l + 1 < DEPTH ? XN + (size_t)m * D_MODEL : nullptr, lane_);
        }
        SEAM(pb + 5);
    }
#undef IN
#undef SEAM
}

__device__ __forceinline__ float sigmoidf_(float x) { return 1.f / (1.f + expf(-x)); }
__device__ __forceinline__ float gelu_tanh(float x) { const float c = 0.7978845608028654f; return 0.5f * x * (1.f + tanhf(c * (x + 0.044715f * x * x * x))); }
__global__ void __launch_bounds__(256) k_attn16(const half_t* Q, const half_t* K, const half_t* V, const float* kmean, const half_t* ZA, half_t* OSA) {
    __shared__ float qs[HD];
    __shared__ float sc[4 * MOBA_BLK];
    __shared__ float red[256];
    __shared__ int selb[4];
    __shared__ float gate[NBLK];
    const int t = blockIdx.x, h = blockIdx.y, b = blockIdx.z, tid = threadIdx.x;
    const int m = b * SEQ + t, own = t / MOBA_BLK;
    const size_t hb = (size_t)(b * NH + h) * SEQ * HD;
    if (tid < HD) qs[tid] = (float)Q[hb + (size_t)t * HD + tid];
    __syncthreads();
    if (tid < NBLK) { float g = 0.f; const float* km = kmean + ((size_t)(b * NH + h) * NBLK + tid) * HD; for (int d = 0; d < HD; ++d) g += qs[d] * (km[d] + km[d + BATCH * NH * NBLK * HD]); gate[tid] = g; }
    __syncthreads();
    if (tid == 0) {
        selb[0] = own; int ns = 1; unsigned used = 0u;
        for (int k = 0; k < TOPK; ++k) { int best = -1; float bv = 0.f; for (int j = 0; j < own; ++j) if (!((used >> j) & 1u) && (best < 0 || gate[j] > bv)) { best = j; bv = gate[j]; }
            if (best >= 0) { used |= 1u << best; selb[ns++] = best; } }
        for (; ns < 4; ++ns) selb[ns] = -1;
    }
    __syncthreads();
    const float scale = 0.08838834764831845f;
    float mx = -INFINITY;
    for (int s = 0; s < 4; ++s) {
        const int blk = selb[s]; float v = -INFINITY;
        if (blk >= 0) { const int kp = blk * MOBA_BLK + tid;
            if (kp <= t) { const half_t* kr = K + hb + (size_t)kp * HD; float a = 0.f; for (int d = 0; d < HD; ++d) a += qs[d] * (float)kr[d]; v = a * scale; } }
        sc[s * MOBA_BLK + tid] = v; mx = fmaxf(mx, v);
    }
    red[tid] = mx; __syncthreads();
    for (int o = 128; o > 0; o >>= 1) { if (tid < o) red[tid] = fmaxf(red[tid], red[tid + o]); __syncthreads(); }
    mx = red[0]; __syncthreads();
    float sum = 0.f;
    for (int s = 0; s < 4; ++s) { const float v = sc[s * MOBA_BLK + tid]; const float p = (v == -INFINITY) ? 0.f : expf(v - mx); sc[s * MOBA_BLK + tid] = p; sum += p; }
    red[tid] = sum; __syncthreads();
    for (int o = 128; o > 0; o >>= 1) { if (tid < o) red[tid] += red[tid + o]; __syncthreads(); }
    sum = red[0]; __syncthreads();
    const int d = tid & 127, hf = tid >> 7; float acc = 0.f;
    for (int s = 0; s < 4; ++s) { const int blk = selb[s]; if (blk < 0) continue;
        for (int kk = hf * 128; kk < hf * 128 + 128; ++kk) { const float p = sc[s * MOBA_BLK + kk]; if (p != 0.f) acc += p * (float)V[hb + (size_t)(blk * MOBA_BLK + kk) * HD + d]; } }
    red[tid] = acc; __syncthreads();
    if (tid < 128) { const float o = (red[tid] + red[tid + 128]) / sum; const float z = (float)ZA[(size_t)m * ATT_W + h * HD + d];
        OSA[(size_t)m * BR_K + SSM_W + h * HD + d] = (half_t)(o * z); }
}
__global__ void k_s5_scan16(const half_t* U, const float* lam_re, const float* lam_im, const float* log_dt, const float* b_re, const float* b_im, float2* X) {
    const int idx = blockIdx.x * blockDim.x + threadIdx.x;
    if (idx >= BATCH * SSM_G * SSM_P) return;
    const int p = idx % SSM_P, g = (idx / SSM_P) % SSM_G, b = idx / (SSM_P * SSM_G);
    const float lr = lam_re[g * SSM_P + p], li = lam_im[g * SSM_P + p], dt = expf(log_dt[g]);
    const float mag = expf(lr * dt), are = mag * cosf(li * dt), aim = mag * sinf(li * dt);
    const float den = lr * lr + li * li, nr = are - 1.f, ni = aim;
    const float fre = (nr * lr + ni * li) / den, fim = (ni * lr - nr * li) / den;
    float bbr[SSM_GC], bbi[SSM_GC];
#pragma unroll
    for (int c = 0; c < SSM_GC; ++c) { const float br = b_re[(g * SSM_P + p) * SSM_GC + c], bi = b_im[(g * SSM_P + p) * SSM_GC + c]; bbr[c] = fre * br - fim * bi; bbi[c] = fre * bi + fim * br; }
    float xr = 0.f, xi = 0.f;
    for (int t = 0; t < SEQ; ++t) {
        const half_t* u = U + (size_t)(b * SEQ + t) * SSM_W + g * SSM_GC; float ur = 0.f, ui = 0.f;
#pragma unroll
        for (int c = 0; c < SSM_GC; ++c) { const float uc = (float)u[c]; ur += bbr[c] * uc; ui += bbi[c] * uc; }
        const float nxr = are * xr - aim * xi + ur, nxi = are * xi + aim * xr + ui; xr = nxr; xi = nxi;
        X[((size_t)(b * SEQ + t) * SSM_G + g) * SSM_P + p] = make_float2(xr, xi);
    }
}
__global__ void k_s5_out16(const half_t* U, const float2* X, const float* c_re, const float* c_im, const float* d_skip, half_t* YS) {
    const int idx = blockIdx.x * blockDim.x + threadIdx.x;
    if (idx >= M * SSM_W) return;
    const int ch = idx % SSM_W, m = idx / SSM_W, g = ch / SSM_GC, c = ch % SSM_GC;
    const float2* x = X + ((size_t)m * SSM_G + g) * SSM_P; float y = 0.f;
    for (int p = 0; p < SSM_P; ++p) y += x[p].x * c_re[(g * SSM_GC + c) * SSM_P + p] - x[p].y * c_im[(g * SSM_GC + c) * SSM_P + p];
    y += d_skip[ch] * (float)U[(size_t)m * SSM_W + ch];
    YS[idx] = (half_t)gelu_tanh(y);
}


extern "C" void kernel_launch(void* const* d_in, const int* in_sizes, int n_in, void* d_out, int out_size, void* d_ws, size_t ws_size, hipStream_t stream) {
    static int grid = 0;
    if (grid == 0) {
        if (n_in != 17 || out_size != M * D_MODEL || ws_size < WS_END) { fprintf(stderr, "kernel_launch: unexpected shapes (n_in %d out %d ws %zu need %zu)\n", n_in, out_size, ws_size, (size_t)WS_END); grid = -1; return; }
        int dev = 0, cus = 0, per_cu = 0;
        if (hipGetDevice(&dev) != hipSuccess || hipDeviceGetAttribute(&cus, hipDeviceAttributeMultiprocessorCount, dev) != hipSuccess) { grid = -1; return; }
        if (hipFuncSetAttribute((const void*)mk_fwd, hipFuncAttributeMaxDynamicSharedMemorySize, LDS_BYTES) != hipSuccess) { fprintf(stderr, "kernel_launch: hipFuncSetAttribute failed\n"); grid = -1; return; }
        if (hipOccupancyMaxActiveBlocksPerMultiprocessor(&per_cu, (const void*)mk_fwd, NWAVES * 64, LDS_BYTES) != hipSuccess || per_cu < 1) fprintf(stderr, "kernel_launch: occupancy query says %d\n", per_cu);
        (void)hipGetLastError();
        grid = cus;
    }
    if (grid < 0) return;
    (void)hipMemsetAsync((char*)d_ws + WS_CTL, 0, CTL_ZERO_BYTES, stream);
    Args a{};
    for (int i = 0; i < 17; ++i) a.in[i] = (const float*)d_in[i];
    a.out = (float*)d_out; a.ws = (unsigned char*)d_ws;
    unsigned char* ws = (unsigned char*)d_ws;
    auto run = [&](int lo, int hi) { a.ph_lo = lo; a.ph_hi = hi; hipLaunchKernelGGL(mk_fwd, dim3(grid), dim3(NWAVES * 64), LDS_BYTES, stream, a); };
    run(0, N_PHASES);
}
```

```cpp
#include <hip/hip_runtime.h>
#include <cstdio>
#include <cstdint>
#include <cmath>

constexpr int D_MODEL = 2048, BATCH = 4, SEQ = 2048, DEPTH = 2;
constexpr int M = BATCH * SEQ;
constexpr int SSM_W = 1024, SSM_GC = 16, SSM_G = 64, SSM_P = 64;
constexpr int NH = 16, HD = 128, ATT_W = 2048;
constexpr int MOBA_BLK = 256, NBLK = SEQ / MOBA_BLK, TOPK = 3;
constexpr int ROT = 32, ROT_H = 16;
constexpr int IN_W = 14336;
constexpr int BR_K = SSM_W + ATT_W;
constexpr float EPS = 1e-6f;

#define GAS __attribute__((address_space(1)))
#define LAS __attribute__((address_space(3)))
typedef _Float16 half_t;
typedef _Float16 h8 __attribute__((ext_vector_type(8)));
typedef _Float16 h4 __attribute__((ext_vector_type(4)));
typedef _Float16 h2 __attribute__((ext_vector_type(2)));
typedef float f32x2 __attribute__((ext_vector_type(2)));
typedef float f32x4 __attribute__((ext_vector_type(4)));
typedef float f32x16 __attribute__((ext_vector_type(16)));
typedef unsigned u32x2 __attribute__((ext_vector_type(2)));
typedef unsigned u32x4 __attribute__((ext_vector_type(4)));
typedef GAS unsigned gu32;

__device__ __forceinline__ unsigned pk2h(float lo, float hi) { f32x2 v = {lo, hi}; h2 h = __builtin_convertvector(v, h2); return __builtin_bit_cast(unsigned, h); }
__device__ __forceinline__ u32x4 pk8h(f32x4 a, f32x4 b) { u32x4 w; w.x = pk2h(a[0], a[1]); w.y = pk2h(a[2], a[3]); w.z = pk2h(b[0], b[1]); w.w = pk2h(b[2], b[3]); return w; }
__device__ __forceinline__ void unpk8h(u32x4 w, f32x4& a, f32x4& b) { h8 h = __builtin_bit_cast(h8, w); a = (f32x4){(float)h[0], (float)h[1], (float)h[2], (float)h[3]}; b = (f32x4){(float)h[4], (float)h[5], (float)h[6], (float)h[7]}; }
__device__ __forceinline__ float fast_sigmoid(float x) { return __builtin_amdgcn_rcpf(1.f + __builtin_amdgcn_exp2f(-1.4426950408889634f * x)); }
__device__ __forceinline__ float fast_silu(float x) { return x * fast_sigmoid(x); }
__device__ __forceinline__ float gelu_tanh_f(float x) {
    const float u = 0.7978845608028654f * (x + 0.044715f * x * x * x); return x * fast_sigmoid(2.f * u); }

typedef short bf8_t __attribute__((ext_vector_type(8)));
__device__ __forceinline__ unsigned pk2bf(float lo, float hi) { unsigned r; asm volatile("v_cvt_pk_bf16_f32 %0, %1, %2" : "=v"(r) : "v"(lo), "v"(hi)); return r; }
#ifndef G1_BF16
#define G1_BF16 0
#endif
__device__ __forceinline__ unsigned pk2x(float lo, float hi) { return G1_BF16 ? pk2bf(lo, hi) : pk2h(lo, hi); }
namespace pg8 {
#define PG8_LAS __attribute__((address_space(3)))
constexpr int BM = 256, BK = 64, HALF = 128, HTB = HALF * BK * 2  , STAGE_BYTES = 8 * HTB, NXCD = 8, WGM = 8;

__host__ __device__ __forceinline__ int lds_byte(int r, int c) { const int st = (r >> 4) * 2 + (c >> 5), rr = r & 15, cc = c & 31, ob = rr * 64 + cc * 2; return st * 1024 + (ob ^ (((ob >> 9) & 1) << 5)); }
__host__ __device__ __forceinline__ void stage_rc(int b, int& R, int& C) { const int st = b / 1024, sb = b % 1024, swz = sb ^ (((sb >> 9) & 1) << 5); R = (st >> 1) * 16 + swz / 64; C = (st & 1) * 32 + (swz % 64) / 2; }
__host__ __device__ __forceinline__ int perm32(int rho) { const int n = rho >> 4, i = rho & 15; return 8 * (i >> 2) + 4 * n + (i & 3); }

struct Unit { int pm, pn; };
struct Gemm { const half_t* A; const half_t* Bt; int M, N, K; };

struct StaticOrder {
    int nM, nN, nwg, G, c;
    __host__ __device__ void init(int M, int N, int G_, int c_) { nM = M / BM; nN = N / BM; nwg = nM * nN; G = G_; c = c_; }
    __host__ __device__ bool next(int i, Unit& u) const {
#ifdef EXP_REV_ORDER
        if ((long)i * G + c >= nwg) return false; const int nr_ = (nwg - c + G - 1) / G; const long L = (long)(nr_ - 1 - i) * G + c;
#else
        const long L = (long)i * G + c; if (L >= nwg) return false;
#endif
        int wgid = (int)L; { const int q = nwg / NXCD, r = nwg % NXCD, xcd = wgid % NXCD, off = wgid / NXCD; wgid = (xcd < r ? xcd * (q + 1) : r * (q + 1) + (xcd - r) * q) + off; }
        const int nig = WGM * nN, gid = wgid / nig, fm = gid * WGM, gsz = (nM - fm) < WGM ? (nM - fm) : WGM;
        u.pm = fm + ((wgid % nig) % gsz); u.pn = (wgid % nig) / gsz; return true;
    }
    __device__ __forceinline__ void a_ready(const Unit&) const {}
    __device__ __forceinline__ void done(const Unit&) const {}
};

typedef f32x4 acc_t[2][2][4][2];
constexpr int KMEAN_PART = BATCH * NH * NBLK * HD;
constexpr size_t EPI_MiB = 1u << 20, EPI_WS_U = 192 * EPI_MiB, EPI_WS_ZS = 208 * EPI_MiB, EPI_WS_Q = 224 * EPI_MiB, EPI_WS_QKV_STRIDE = 32 * EPI_MiB, EPI_WS_ZA = 320 * EPI_MiB, EPI_WS_G_STRIDE = 32 * EPI_MiB;
typedef __amdgpu_buffer_rsrc_t rsrc_t;
__device__ __forceinline__ rsrc_t mkrsrc(const void* p, size_t bytes) { return __builtin_amdgcn_make_buffer_rsrc((void*)p, (short)0, (int)bytes, 0x00020000); }
__device__ __forceinline__ u32x4 bld128(rsrc_t r, unsigned voff, unsigned soff) { return __builtin_amdgcn_raw_buffer_load_b128(r, voff, soff, 0); }
#ifndef ST_AUX
#define ST_AUX 0
#endif
__device__ __forceinline__ void bst128(u32x4 v, rsrc_t r, unsigned voff, unsigned soff) { __builtin_amdgcn_raw_buffer_store_b128(v, r, voff, soff, ST_AUX); }
__device__ __forceinline__ void bst128_wt(u32x4 v, rsrc_t r, unsigned voff, unsigned soff) { __builtin_amdgcn_raw_buffer_store_b128(v, r, voff, soff, 16); }
__device__ __forceinline__ void bst64(u32x2 v, rsrc_t r, unsigned voff, unsigned soff) { __builtin_amdgcn_raw_buffer_store_b64(v, r, voff, soff, ST_AUX); }

struct EpiIn {
    static constexpr bool BF16_IN = G1_BF16;
    static constexpr bool PERM = false, AFTER_DRAIN = false, HAS_MID = false, A_GROUPED = false; static constexpr int MID_T = -1;
    unsigned char* ws; float* kmean; const float* rope;
    __device__ __forceinline__ void mid(acc_t&, const Unit&, int, int, int, int) const {}
    __device__ __forceinline__ void operator()(const acc_t& acc, const Unit& u, int wr, int wc, int fr, int fq) const {
        const int pn = u.pn, pm = u.pm;
        if (pn < 8 || pn >= 32) {
            size_t boff; int ldc, colt, act;
            if (pn < 4) { boff = EPI_WS_U; ldc = SSM_W; colt = pn * 256; act = 0; }
            else if (pn < 8) { boff = EPI_WS_ZS; ldc = SSM_W; colt = (pn - 4) * 256; act = 1; }
            else { boff = EPI_WS_ZA + (size_t)((pn - 32) >> 3) * EPI_WS_G_STRIDE; ldc = D_MODEL; colt = ((pn - 32) & 7) * 256; act = pn < 40 ? 1 : 2; }
            const rsrc_t rs = mkrsrc(ws + boff, (size_t)M * ldc * 2);
            const unsigned lo = (unsigned)((wr * 64 + fr) * ldc + wc * 32 + 8 * fq) * 2u, so0 = (unsigned)(pm * BM * ldc + colt) * 2u;
#pragma unroll
            for (int ai = 0; ai < 2; ++ai)
#pragma unroll
                for (int m = 0; m < 4; ++m) {
#pragma unroll
                    for (int bj = 0; bj < 2; ++bj) { f32x4 v0 = acc[ai][bj][m][0], v1 = acc[ai][bj][m][1];
                        if (act == 1) {
#pragma unroll
                            for (int e = 0; e < 4; ++e) { v0[e] = fast_silu(v0[e]); v1[e] = fast_silu(v1[e]); } }
                        else if (act == 2) {
#pragma unroll
                            for (int e = 0; e < 4; ++e) { v0[e] = fast_sigmoid(v0[e]); v1[e] = fast_sigmoid(v1[e]); } }
                        bst128(pk8h(v0, v1), rs, lo, so0 + (unsigned)((ai * HALF + m * 16) * ldc + bj * HALF) * 2u); } }
            return;
        }
        const int which = (pn - 8) >> 3, head0 = ((pn - 8) & 7) * 2, b = pm >> 3, blk = pm & 7;
        const rsrc_t rs = mkrsrc(ws + EPI_WS_Q + (size_t)which * EPI_WS_QKV_STRIDE, (size_t)M * ATT_W * 2), rr = mkrsrc(rope, (size_t)SEQ * 32 * 4);
        const bool rot = (which < 2) && (wc == 0);
        const unsigned lo = (unsigned)((wr * 64 + fr) * HD + (rot ? 4 * fq : wc * 32 + 8 * fq)) * 2u;
        const unsigned lr = (unsigned)((wr * 64 + fr) * 32 + 4 * fq) * 4u;
#pragma unroll
        for (int bj = 0; bj < 2; ++bj) {
            const unsigned sh = (unsigned)(((b * NH + head0 + bj) * SEQ + blk * 256) * HD) * 2u;
            f32x4 cs0 = {0.f, 0.f, 0.f, 0.f}, cs1 = {0.f, 0.f, 0.f, 0.f};
#pragma unroll
            for (int ai = 0; ai < 2; ++ai)
#pragma unroll
                for (int m = 0; m < 4; ++m) { const unsigned ro = (unsigned)(ai * HALF + m * 16);
                    f32x4 v0 = acc[ai][bj][m][0], v1 = acc[ai][bj][m][1];
                    if (rot) { const unsigned st = (unsigned)(blk * 256 + ro) * 128u;
                        const f32x4 c = __builtin_bit_cast(f32x4, bld128(rr, lr, st)), s = __builtin_bit_cast(f32x4, bld128(rr, lr, st + 64u));
                        const f32x4 o1 = v0 * c - v1 * s, o2 = v1 * c + v0 * s; v0 = o1; v1 = o2;
                        u32x2 w0 = {pk2h(v0[0], v0[1]), pk2h(v0[2], v0[3])}, w1 = {pk2h(v1[0], v1[1]), pk2h(v1[2], v1[3])};
                        bst64(w0, rs, lo, sh + ro * (HD * 2)); bst64(w1, rs, lo, sh + ro * (HD * 2) + 32u); }
                    else bst128(pk8h(v0, v1), rs, lo, sh + ro * (HD * 2));
                    cs0 += v0; cs1 += v1; }
            if (which == 1) {
#pragma unroll
                for (int o = 1; o < 16; o <<= 1)
#pragma unroll
                    for (int e = 0; e < 4; ++e) { cs0[e] += __shfl_xor(cs0[e], o); cs1[e] += __shfl_xor(cs1[e], o); }
                if (fr == 0) { float* km = kmean + (size_t)wr * KMEAN_PART + ((size_t)(b * NH + head0 + bj) * NBLK + blk) * HD;
                    const int d0 = rot ? 4 * fq : wc * 32 + 8 * fq, d1 = rot ? 16 + 4 * fq : wc * 32 + 8 * fq + 4;
                    const rsrc_t rk = mkrsrc(km, (size_t)HD * 4);
                    bst128(__builtin_bit_cast(u32x4, cs0 * (1.f / MOBA_BLK)), rk, (unsigned)d0 * 4u, 0u); bst128(__builtin_bit_cast(u32x4, cs1 * (1.f / MOBA_BLK)), rk, (unsigned)d1 * 4u, 0u); }
            }
        }
    }
};

struct EpiGlu {
    static constexpr bool BF16_IN = false;
    static constexpr bool PERM = false, AFTER_DRAIN = false, HAS_MID = false, A_GROUPED = true; static constexpr int MID_T = -1;
    const half_t *YS, *ZS; const float* bias; half_t* OSA;
    __device__ __forceinline__ void mid(acc_t&, const Unit&, int, int, int, int) const {}
    __device__ __forceinline__ void operator()(const acc_t& acc, const Unit& u, int wr, int wc, int fr, int fq) const {
        const rsrc_t ry = mkrsrc(YS, (size_t)M * SSM_W * 2), rz = mkrsrc(ZS, (size_t)M * SSM_W * 2), ro = mkrsrc(OSA, (size_t)M * BR_K * 2), rb = mkrsrc(bias, (size_t)SSM_W * 4);
        const unsigned li = (unsigned)((wr * 64 + fr) * SSM_W + wc * 32 + 8 * fq) * 2u, lo = (unsigned)((wr * 64 + fr) * BR_K + wc * 32 + 8 * fq) * 2u, lb = (unsigned)(wc * 32 + 8 * fq) * 4u;
        const unsigned ly = (unsigned)((((wc * 32 + 8 * fq) >> 4) * SEQ + wr * 64 + fr) * 32 + ((8 * fq) & 15) * 2);
        const unsigned si = (unsigned)(u.pm * BM * SSM_W + u.pn * BM) * 2u, so = (unsigned)(u.pm * BM * BR_K + u.pn * BM) * 2u, sb = (unsigned)(u.pn * BM) * 4u;
        const unsigned sy = (unsigned)((((u.pm >> 3) * SSM_G + u.pn * (BM / 16)) * SEQ + (u.pm & 7) * BM) * 32);
#pragma unroll
        for (int bj = 0; bj < 2; ++bj) { const f32x4 b0 = __builtin_bit_cast(f32x4, bld128(rb, lb, sb + bj * HALF * 4)), b1 = __builtin_bit_cast(f32x4, bld128(rb, lb, sb + bj * HALF * 4 + 16));
#pragma unroll
            for (int ai = 0; ai < 2; ++ai)
#pragma unroll
                for (int m = 0; m < 4; ++m) { const unsigned r = (unsigned)(ai * HALF + m * 16);
                    f32x4 y0, y1, z0, z1; unpk8h(bld128(ry, ly, sy + (unsigned)((bj * (HALF / 16) * SEQ + r) * 32)), y0, y1); unpk8h(bld128(rz, li, si + (r * SSM_W + bj * HALF) * 2u), z0, z1);
                    f32x4 v0 = acc[ai][bj][m][0] + b0, v1 = acc[ai][bj][m][1] + b1;
#pragma unroll
                    for (int e = 0; e < 4; ++e) { v0[e] = y0[e] * fast_sigmoid(v0[e]) * z0[e]; v1[e] = y1[e] * fast_sigmoid(v1[e]) * z1[e]; }
                    bst128(pk8h(v0, v1), ro, lo, so + (r * BR_K + bj * HALF) * 2u); } }
    }
};

struct EpiMerge {
    static constexpr bool BF16_IN = false;
    static constexpr bool PERM = false, AFTER_DRAIN = false, HAS_MID = true, A_GROUPED = false; static constexpr int MID_T = SSM_W / BK;
    const half_t *GS, *GA; half_t* MG;
    __device__ __forceinline__ void mid(acc_t& acc, const Unit& u, int wr, int wc, int fr, int fq) const {
        const rsrc_t rs = mkrsrc(GS, (size_t)M * D_MODEL * 2), ra = mkrsrc(GA, (size_t)M * D_MODEL * 2);
        const unsigned lo = (unsigned)((wr * 64 + fr) * D_MODEL + wc * 32 + 8 * fq) * 2u, so = (unsigned)(u.pm * BM * D_MODEL + u.pn * BM) * 2u;
#pragma unroll
        for (int ai = 0; ai < 2; ++ai)
#pragma unroll
            for (int m = 0; m < 4; ++m)
#pragma unroll
                for (int bj = 0; bj < 2; ++bj) { const unsigned o = so + (unsigned)((ai * HALF + m * 16) * D_MODEL + bj * HALF) * 2u;
                    f32x4 s0, s1, a0, a1; unpk8h(bld128(rs, lo, o), s0, s1); unpk8h(bld128(ra, lo, o), a0, a1);
#pragma unroll
                    for (int e = 0; e < 4; ++e) { acc[ai][bj][m][0][e] *= s0[e] * __builtin_amdgcn_rcpf(fmaxf(a0[e], 6.2e-5f)); acc[ai][bj][m][1][e] *= s1[e] * __builtin_amdgcn_rcpf(fmaxf(a1[e], 6.2e-5f)); } }
    }
    __device__ __forceinline__ void operator()(const acc_t& acc, const Unit& u, int wr, int wc, int fr, int fq) const {
        const rsrc_t ra = mkrsrc(GA, (size_t)M * D_MODEL * 2), rm = mkrsrc(MG, (size_t)M * D_MODEL * 2);
        const unsigned lo = (unsigned)((wr * 64 + fr) * D_MODEL + wc * 32 + 8 * fq) * 2u, so = (unsigned)(u.pm * BM * D_MODEL + u.pn * BM) * 2u;
#pragma unroll
        for (int ai = 0; ai < 2; ++ai)
#pragma unroll
            for (int m = 0; m < 4; ++m)
#pragma unroll
                for (int bj = 0; bj < 2; ++bj) { const unsigned o = so + (unsigned)((ai * HALF + m * 16) * D_MODEL + bj * HALF) * 2u;
                    f32x4 a0, a1; unpk8h(bld128(ra, lo, o), a0, a1); f32x4 v0 = acc[ai][bj][m][0], v1 = acc[ai][bj][m][1];
#pragma unroll
                    for (int e = 0; e < 4; ++e) { v0[e] *= fmaxf(a0[e], 6.2e-5f); v1[e] *= fmaxf(a1[e], 6.2e-5f); }
                    bst128(pk8h(v0, v1), rm, lo, o); }
    }
};

struct EpiOut {
    static constexpr bool BF16_IN = false;
    static constexpr bool PERM = false, AFTER_DRAIN = false, HAS_MID = false, A_GROUPED = false; static constexpr int MID_T = -1;
    half_t* OUT;
    __device__ __forceinline__ void mid(acc_t&, const Unit&, int, int, int, int) const {}
    __device__ __forceinline__ void operator()(const acc_t& acc, const Unit& u, int wr, int wc, int fr, int fq) const {
        const rsrc_t ro = mkrsrc(OUT, (size_t)M * D_MODEL * 2);
        const unsigned lo = (unsigned)((wr * 64 + fr) * D_MODEL + wc * 32 + 8 * fq) * 2u, so = (unsigned)(u.pm * BM * D_MODEL + u.pn * BM) * 2u;
#pragma unroll
        for (int ai = 0; ai < 2; ++ai)
#pragma unroll
            for (int m = 0; m < 4; ++m)
#pragma unroll
                for (int bj = 0; bj < 2; ++bj) { const unsigned o = so + (unsigned)((ai * HALF + m * 16) * D_MODEL + bj * HALF) * 2u;
                    bst128(pk8h(acc[ai][bj][m][0], acc[ai][bj][m][1]), ro, lo, o); }
    }
};
template <class Epi, class Sched, bool ALIGN_EPI = false, bool SP2 = false>
__device__ __forceinline__ void gemm_phase(PG8_LAS unsigned char* lds, const Gemm g, const Sched& S, const Epi& E) {
    int tid_ = threadIdx.x; asm volatile("" : "+v"(tid_));
    const int tid = tid_, wid = __builtin_amdgcn_readfirstlane(tid >> 6), lane = tid & 63, wr = wid >> 2, wc = wid & 3, fr = lane & 15, fq = lane >> 4;
    const int K = g.K, nt = K / BK;
    unsigned voffA[2], voffB[2];
#pragma unroll
    for (int i = 0; i < 2; ++i) { int R, C; stage_rc(tid * 16 + i * 8192, R, C); const int Rb = Epi::PERM ? ((R & ~31) + perm32(R & 31)) : R;
        voffA[i] = Epi::A_GROUPED ? (unsigned)(((C >> 4) * SEQ + R) * 32 + (C & 15) * 2) : (unsigned)(R * K + C) * 2u; voffB[i] = (unsigned)(Rb * K + C) * 2u; }
    const size_t kstep = (size_t)(BK * 2);
    const size_t hstep = (size_t)HALF * K * 2;
    const size_t tstep = 2 * hstep;
    const size_t kstepA = Epi::A_GROUPED ? (size_t)(BK / 16) * SEQ * 32 : kstep, hstepA = Epi::A_GROUPED ? (size_t)HALF * 32 : hstep;
#define PG8_ABASE(pm) (Epi::A_GROUPED ? (const char*)g.A + ((size_t)((pm) >> 3) * (K / 16) * SEQ + (size_t)((pm) & 7) * BM) * 32 : (const char*)g.A + (size_t)(pm) * tstep)
    const unsigned ldsw = (unsigned)wid * 1024u;
    const int aoff = lds_byte(wr * 64 + fr, fq * 8), boff = lds_byte(wc * 32 + fr, fq * 8);
#define PG8_SA(b, h) (((b) * 2 + (h)) * HTB)
#define PG8_SB(b, h) ((4 + (b) * 2 + (h)) * HTB)
#define PG8_STAGE(bufoff, gbase, voff) do { _Pragma("unroll") for (int _i = 0; _i < 2; ++_i) \
        __builtin_amdgcn_global_load_lds((const unsigned*)((const char*)(gbase) + (voff)[_i]), (PG8_LAS unsigned*)(lds + (bufoff) + ldsw + _i * 8192), 16, 0, 0); } while (0)
#define PG8_LDA(dst, b, h) do { _Pragma("unroll") for (int m = 0; m < 4; ++m) _Pragma("unroll") for (int k = 0; k < 2; ++k) dst[m][k] = *(const PG8_LAS h8*)(lds + PG8_SA(b, h) + aoff + m * 2048 + k * 1024); } while (0)
#define PG8_LDB(dst, b, h) do { _Pragma("unroll") for (int n = 0; n < 2; ++n) _Pragma("unroll") for (int k = 0; k < 2; ++k) dst[n][k] = *(const PG8_LAS h8*)(lds + PG8_SB(b, h) + boff + n * 2048 + k * 1024); } while (0)
#define PG8_MMA(ai, bj, At, Bt) do { __builtin_amdgcn_s_setprio(1); _Pragma("unroll") for (int m = 0; m < 4; ++m) _Pragma("unroll") for (int n = 0; n < 2; ++n) _Pragma("unroll") for (int k = 0; k < 2; ++k) \
        acc[ai][bj][m][n] = Epi::BF16_IN ? __builtin_amdgcn_mfma_f32_16x16x32_bf16(__builtin_bit_cast(bf8_t, Bt[n][k]), __builtin_bit_cast(bf8_t, At[m][k]), acc[ai][bj][m][n], 0, 0, 0) \
                                         : __builtin_amdgcn_mfma_f32_16x16x32_f16(Bt[n][k], At[m][k], acc[ai][bj][m][n], 0, 0, 0); __builtin_amdgcn_s_setprio(0); } while (0)
#define PG8_WAIT_V(n) asm volatile("s_waitcnt vmcnt(" #n ")" ::: "memory")
#define PG8_WAIT_L(n) asm volatile("s_waitcnt lgkmcnt(" #n ")" ::: "memory")
#define PG8_BAR __builtin_amdgcn_s_barrier()
#define PG8_SCHED __builtin_amdgcn_sched_barrier(0)
    Unit cur, nxt; int ui = 0;
    if (!S.next(0, cur)) return;
    f32x4 acc[2][2][4][2];
#pragma unroll
    for (int a = 0; a < 2; ++a)
#pragma unroll
        for (int b = 0; b < 2; ++b)
#pragma unroll
            for (int m = 0; m < 4; ++m)
#pragma unroll
                for (int n = 0; n < 2; ++n) acc[a][b][m][n] = (f32x4){0.f, 0.f, 0.f, 0.f};
    h8 At[4][2], B0[2][2], B1[2][2];
    const char* cA = PG8_ABASE(cur.pm); const char* cB = (const char*)g.Bt + (size_t)cur.pn * tstep;
    S.a_ready(cur);
    if constexpr (SP2) {
        PG8_STAGE(PG8_SB(0, 0), cB, voffB); PG8_STAGE(PG8_SB(0, 1), cB + hstep, voffB); PG8_STAGE(PG8_SA(0, 0), cA, voffA); PG8_STAGE(PG8_SA(0, 1), cA + hstepA, voffA);
        if (wr == 1) PG8_BAR;
        PG8_WAIT_V(2); PG8_BAR;
        PG8_STAGE(PG8_SB(1, 0), cB + kstep, voffB); PG8_STAGE(PG8_SA(1, 0), cA + kstepA, voffA); PG8_STAGE(PG8_SB(1, 1), cB + hstep + kstep, voffB);
        PG8_WAIT_V(6); PG8_BAR;
    } else {
        PG8_STAGE(PG8_SB(0, 0), cB, voffB); PG8_STAGE(PG8_SA(0, 0), cA, voffA); PG8_STAGE(PG8_SB(0, 1), cB + hstep, voffB); PG8_STAGE(PG8_SA(0, 1), cA + hstepA, voffA);
        if (wr == 1) PG8_BAR;
        PG8_WAIT_V(4); PG8_BAR;
        PG8_STAGE(PG8_SB(1, 0), cB + kstep, voffB); PG8_STAGE(PG8_SA(1, 0), cA + kstepA, voffA); PG8_STAGE(PG8_SB(1, 1), cB + hstep + kstep, voffB);
        PG8_WAIT_V(6); PG8_BAR;
    }
    for (;;) {
        const bool has_next = S.next(ui + 1, nxt);
        const char* nA = has_next ? PG8_ABASE(nxt.pm) : cA; const char* nB = has_next ? (const char*)g.Bt + (size_t)nxt.pn * tstep : cB;
        for (int t = 0; t < nt; t += 2) {
            if constexpr (Epi::HAS_MID) { if (t == Epi::MID_T) E.mid(acc, cur, wr, wc, fr, fq); }
            const bool last = (t == nt - 2);
            const char* a1 = cA + (size_t)(t + 1) * kstepA;
            const char* a2 = last ? nA : cA + (size_t)(t + 2) * kstepA; const char* b2 = last ? nB : cB + (size_t)(t + 2) * kstep;
            const char* a3 = a2 + kstepA; const char* b3 = b2 + kstep;
            if (last && has_next) S.a_ready(nxt);
            if constexpr (SP2) {
            PG8_LDB(B0, 0, 0); PG8_LDB(B1, 0, 1); PG8_SCHED; PG8_LDA(At, 0, 0); PG8_STAGE(PG8_SA(1, 1), a1 + hstepA, voffA);
            PG8_WAIT_V(8); PG8_WAIT_L(0); PG8_BAR; PG8_MMA(0, 0, At, B0); PG8_MMA(0, 1, At, B1); PG8_BAR; PG8_SCHED;
            PG8_LDA(At, 0, 1); PG8_STAGE(PG8_SB(0, 0), b2, voffB); PG8_STAGE(PG8_SB(0, 1), b2 + hstep, voffB); PG8_STAGE(PG8_SA(0, 0), a2, voffA);
            PG8_WAIT_V(8); PG8_WAIT_L(0); PG8_BAR; PG8_MMA(1, 0, At, B0); PG8_MMA(1, 1, At, B1); PG8_BAR; PG8_SCHED;
            PG8_LDB(B0, 1, 0); PG8_LDB(B1, 1, 1); PG8_SCHED; PG8_LDA(At, 1, 0); PG8_STAGE(PG8_SA(0, 1), a2 + hstepA, voffA);
            PG8_WAIT_V(8); PG8_WAIT_L(0); PG8_BAR; PG8_MMA(0, 0, At, B0); PG8_MMA(0, 1, At, B1); PG8_BAR; PG8_SCHED;
            PG8_LDA(At, 1, 1); PG8_STAGE(PG8_SB(1, 0), b3, voffB); PG8_STAGE(PG8_SB(1, 1), b3 + hstep, voffB); PG8_STAGE(PG8_SA(1, 0), a3, voffA);
            PG8_WAIT_V(8); PG8_WAIT_L(0); PG8_BAR; PG8_MMA(1, 0, At, B0); PG8_MMA(1, 1, At, B1); PG8_BAR; PG8_SCHED;
            } else {
            PG8_LDB(B0, 0, 0); PG8_SCHED; PG8_LDA(At, 0, 0); PG8_STAGE(PG8_SA(1, 1), a1 + hstepA, voffA);
            PG8_WAIT_L(8); PG8_BAR; PG8_WAIT_L(0); PG8_MMA(0, 0, At, B0); PG8_BAR; PG8_SCHED;
            PG8_LDB(B1, 0, 1); PG8_STAGE(PG8_SB(0, 0), b2, voffB);
            PG8_BAR; PG8_WAIT_L(0); PG8_MMA(0, 1, At, B1); PG8_BAR;
            PG8_LDA(At, 0, 1); PG8_STAGE(PG8_SA(0, 0), a2, voffA);
            PG8_BAR; PG8_WAIT_L(0); PG8_MMA(1, 0, At, B0); PG8_BAR; PG8_SCHED;
            PG8_STAGE(PG8_SB(0, 1), b2 + hstep, voffB);
            PG8_WAIT_V(6); PG8_BAR; PG8_MMA(1, 1, At, B1); PG8_BAR;
            PG8_LDB(B0, 1, 0); PG8_SCHED; PG8_LDA(At, 1, 0); PG8_STAGE(PG8_SA(0, 1), a2 + hstepA, voffA);
            PG8_WAIT_L(8); PG8_BAR; PG8_WAIT_L(0); PG8_MMA(0, 0, At, B0); PG8_BAR; PG8_SCHED;
            PG8_LDB(B1, 1, 1); PG8_STAGE(PG8_SB(1, 0), b3, voffB);
            PG8_BAR; PG8_WAIT_L(0); PG8_MMA(0, 1, At, B1); PG8_BAR;
            PG8_LDA(At, 1, 1); PG8_STAGE(PG8_SA(1, 0), a3, voffA);
            PG8_BAR; PG8_WAIT_L(0); PG8_MMA(1, 0, At, B0); PG8_BAR; PG8_SCHED;
            PG8_STAGE(PG8_SB(1, 1), b3 + hstep, voffB);
            PG8_WAIT_V(6); PG8_BAR; PG8_MMA(1, 1, At, B1); PG8_BAR;
            }
        }
        asm volatile("s_nop 15" :: "v"(At[3][1]), "v"(B0[1][1]), "v"(B1[1][1]));
        if constexpr (ALIGN_EPI) { if (wr == 0) PG8_BAR; }
        if constexpr (!Epi::AFTER_DRAIN) { E(acc, cur, wr, wc, fr, fq); S.done(cur); }
        if (!has_next) break;
#pragma unroll
        for (int a = 0; a < 2; ++a)
#pragma unroll
            for (int b = 0; b < 2; ++b)
#pragma unroll
                for (int m = 0; m < 4; ++m)
#pragma unroll
                    for (int n = 0; n < 2; ++n) acc[a][b][m][n] = (f32x4){0.f, 0.f, 0.f, 0.f};
        cur = nxt; cA = nA; cB = nB; ++ui;
        if constexpr (ALIGN_EPI) { if (wr == 1) PG8_BAR; }
    }
    PG8_WAIT_V(0);
    if constexpr (!ALIGN_EPI) { if (wr == 0) PG8_BAR; }
    PG8_BAR;
    if constexpr (Epi::AFTER_DRAIN) { E.fused(acc, cur, wr, wc, fr, fq, lds, wid, lane); S.done(cur); }
#undef PG8_ABASE
#undef PG8_SA
#undef PG8_SB
#undef PG8_STAGE
#undef PG8_LDA
#undef PG8_LDB
#undef PG8_MMA
#undef PG8_WAIT_V
#undef PG8_WAIT_L
#undef PG8_BAR
#undef PG8_SCHED
}

}

#define RLX_AGENT __ATOMIC_RELAXED, __HIP_MEMORY_SCOPE_AGENT
#define LDS_WAIT() asm volatile("s_waitcnt lgkmcnt(0)" ::: "memory")
#define VM_WAIT() asm volatile("s_waitcnt vmcnt(0)" ::: "memory")
#ifndef XB_SCOPE
#define XB_SCOPE "agent"
#endif
#ifndef XB_RELEASE_WBL2
#define XB_RELEASE_WBL2 1
#endif
#define XB_TMO      128
#define XB_XCNT(j)  (256  + 64 * (j))
#define XB_XSUB(j)  (1280 + 64 * (j))
#define XB_XGEN(j)  (2304 + 64 * (j))
#define XB_TOP      3328
#define XB_TOPGEN   3392
#define XCD_BAR_WORDS 3456
#define XB_SPIN_CAP (1u << 18)

__device__ __forceinline__ unsigned xb_ld(unsigned* p)              { return __hip_atomic_load(p, __ATOMIC_RELAXED, __HIP_MEMORY_SCOPE_AGENT); }
__device__ __forceinline__ unsigned xb_add(unsigned* p, unsigned v) { return __hip_atomic_fetch_add(p, v, __ATOMIC_RELAXED, __HIP_MEMORY_SCOPE_AGENT); }
__device__ __forceinline__ unsigned xb_xcc_id() { return (unsigned)__builtin_amdgcn_s_getreg((3 << 11) | 20) & 0xFu; }
#define XB_SPIN(cond, bar) do { unsigned _sp = 0; while (cond) { __builtin_amdgcn_s_sleep(1); \
    if ((++_sp & 255u) == 0u) { if (xb_ld(&(bar)[XB_TMO])) break; if (_sp > XB_SPIN_CAP) { atomicAdd(&(bar)[XB_TMO], 1u); break; } } } } while (0)

struct XcdBarrier {
    unsigned* bar; unsigned x;
    volatile LAS unsigned* st;
};

__device__ __forceinline__ XcdBarrier xcd_barrier_post(unsigned* bar, volatile LAS unsigned* st) {
    XcdBarrier b; b.bar = bar; b.x = xb_xcc_id(); b.st = st;
    if (threadIdx.x == 0) (void)xb_add(&bar[XB_XCNT(b.x)], 1u);
    return b;
}
__device__ __forceinline__ void xcd_barrier_complete(unsigned* bar, unsigned x, unsigned& nloc, unsigned& nx) {
    const unsigned G = gridDim.x * gridDim.y * gridDim.z;
    unsigned sum, cnt, mine, sp = 0u;
    for (;;) {
        sum = 0u; cnt = 0u; mine = 0u;
#pragma unroll
        for (unsigned j = 0; j < 16; ++j) { const unsigned c = xb_ld(&bar[XB_XCNT(j)]); sum += c; cnt += (c > 0u) ? 1u : 0u; mine = (j == x) ? c : mine; }
        if (sum == G) break;
        __builtin_amdgcn_s_sleep(1);
        if ((++sp & 255u) == 0u) { if (xb_ld(&bar[XB_TMO])) break; if (sp > XB_SPIN_CAP) { atomicAdd(&bar[XB_TMO], 1u); break; } }
    }
    nloc = mine > 0u ? mine : 1u; nx = cnt > 0u ? cnt : 1u;
}

__device__ __forceinline__ void xcd_barrier(const XcdBarrier& b) {
    asm volatile("s_waitcnt vmcnt(0)" ::: "memory");
    __syncthreads();
    if (threadIdx.x == 0) {
        unsigned* bar = b.bar;
        __builtin_amdgcn_s_waitcnt(0);
        unsigned nloc = b.st[0], nx = b.st[1];
        if (nloc == 0u) { xcd_barrier_complete(bar, b.x, nloc, nx); b.st[0] = nloc; b.st[1] = nx; }
        const unsigned old = xb_add(&bar[XB_XSUB(b.x)], 1u);
        const unsigned gen = old / nloc;
        if (old + 1u == (gen + 1u) * nloc) {
#if XB_RELEASE_WBL2
            __builtin_amdgcn_fence(__ATOMIC_RELEASE, XB_SCOPE);
#endif
            asm volatile("s_waitcnt vmcnt(0)" ::: "memory");
            const unsigned og = xb_add(&bar[XB_TOP], 1u);
            const unsigned tg = og / nx;
            if (og + 1u == (tg + 1u) * nx) xb_add(&bar[XB_TOPGEN], 1u);
            else XB_SPIN(xb_ld(&bar[XB_TOPGEN]) == tg, bar);
            __builtin_amdgcn_fence(__ATOMIC_ACQUIRE, XB_SCOPE);
            xb_add(&bar[XB_XGEN(b.x)], 1u);
            asm volatile("s_waitcnt vmcnt(0)" ::: "memory");
        } else {
            XB_SPIN(xb_ld(&bar[XB_XGEN(b.x)]) == gen, bar);
            __builtin_amdgcn_fence(__ATOMIC_ACQUIRE, XB_SCOPE);
            asm volatile("s_waitcnt vmcnt(0)" ::: "memory");
        }
    }
    __syncthreads();
}

constexpr size_t MiB = 1u << 20;
constexpr size_t WS_CTL = 0, CTL_ZERO_BYTES = 1 * MiB;
constexpr size_t WS_KMEAN = 1 * MiB + 512 * 1024;
constexpr size_t WS_ROPE = 1 * MiB;
constexpr size_t WS_S5 = 2 * MiB, S5_STRIDE = 1 * MiB;
constexpr size_t S5_A = 0, S5_BB = 64 * 1024, S5_CM = 320 * 1024, S5_SC = 576 * 1024;
constexpr size_t WS_WIN = 4 * MiB, WIN_STRIDE = 56 * MiB;
constexpr size_t WS_WGLU = 116 * MiB, WGLU_STRIDE = 2 * MiB;
constexpr size_t WS_WBR = 120 * MiB, WBR_STRIDE = 12 * MiB;
constexpr size_t WS_WOUT = 144 * MiB, WOUT_STRIDE = 8 * MiB;
constexpr size_t WS_XN = 160 * MiB, WS_U = 192 * MiB, WS_ZS = 208 * MiB, WS_Q = 224 * MiB, WS_K = 256 * MiB, WS_V = 288 * MiB;
constexpr size_t WS_ZA = 320 * MiB, WS_GS = 352 * MiB, WS_GA = 384 * MiB, WS_YS = 416 * MiB, WS_OSA = 432 * MiB, WS_MG = 480 * MiB, WS_OUT = 512 * MiB;
constexpr size_t WS_XST = 576 * MiB, WS_END = 832 * MiB;
static_assert(pg8::EPI_WS_U == WS_U && pg8::EPI_WS_ZS == WS_ZS && pg8::EPI_WS_Q == WS_Q && WS_K == WS_Q + pg8::EPI_WS_QKV_STRIDE && WS_V == WS_K + pg8::EPI_WS_QKV_STRIDE && pg8::EPI_WS_ZA == WS_ZA && WS_GS == WS_ZA + pg8::EPI_WS_G_STRIDE && WS_GA == WS_GS + pg8::EPI_WS_G_STRIDE, "EpiIn offsets");
constexpr int CW_TMO = 0, CW_CODE = 1, CW_BAR = 4096;

constexpr int RING_OFF = 0, RING_BYTES = 155648;
constexpr int LDSCTL_OFF = RING_BYTES, MISC_OFF = LDSCTL_OFF + 320;
constexpr int LDS_BYTES = 163840;
constexpr int NWAVES = 8;


namespace s5 {
#ifndef S5_UPITCH
#define S5_UPITCH SSM_W
#endif
constexpr int XROW = 304;
constexpr int X_BYTES = 32 * XROW, LDS_E = 8 * X_BYTES, LDS_U = LDS_E + 16 * 64 * 8, LDS_BYTES_S5 = LDS_U + SEQ * 32;
__device__ __forceinline__ void unit(LAS unsigned char* lds, int b, int g, const half_t* U, half_t* YS, const unsigned char* tab, const float* dskip, const float* logdt) {
    int tid_ = threadIdx.x; asm volatile("" : "+v"(tid_));
    const int lane = tid_ & 63, wave = __builtin_amdgcn_readfirstlane(tid_ >> 6);
    const int c = lane & 31, h = lane >> 5, c16 = lane & 15, q4 = lane >> 4;
    const f32x4 A0 = ((const f32x4*)(tab + S5_A))[g * 64 + c], A1 = ((const f32x4*)(tab + S5_A))[g * 64 + 32 + c];
    h8 bbf[4], cmf[4];
#pragma unroll
    for (int t = 0; t < 4; ++t) bbf[t] = *(const h8*)((const half_t*)(tab + S5_BB) + ((size_t)(g * 128 + t * 32 + c) * 16 + 8 * h));
#pragma unroll
    for (int ks = 0; ks < 4; ++ks) cmf[ks] = *(const h8*)((const half_t*)(tab + S5_CM) + ((size_t)(g * 16 + c16) * 128 + 32 * ks + 8 * q4));
    const float isc = 1.f / exp2f(rintf(-logdt[g] * 1.4426950408889634f)), dsk = dskip[g * 16 + c16];
    const int r = lane & 31, s_in = (r >> 2) & 1, j_in = (r & 3) + 4 * (r >> 3);
    LAS unsigned char* Ut = lds + LDS_U;
    {
        const half_t* ub = U + (size_t)b * SEQ * S5_UPITCH + g * 16;
#ifdef S5_U_DMA
#pragma unroll
        for (int i = 0; i < 8; ++i) { const int p = tid_ + 512 * i;
            __builtin_amdgcn_global_load_lds((const unsigned*)(ub + (size_t)(p >> 1) * S5_UPITCH + 8 * (p & 1)), (LAS unsigned*)(Ut + 16 * (wave * 64 + 512 * i)), 16, 0, 0); }
        asm volatile("s_waitcnt vmcnt(0)" ::: "memory");
#else
        h8 t[8];
#pragma unroll
        for (int i = 0; i < 8; ++i) { const int p = tid_ + 512 * i; t[i] = *(const h8*)(ub + (size_t)(p >> 1) * S5_UPITCH + 8 * (p & 1)); }
#pragma unroll
        for (int i = 0; i < 8; ++i) *(LAS h8*)(Ut + 16 * (tid_ + 512 * i)) = t[i];
#endif
    }
    __syncthreads();
    const LAS unsigned char* urow = Ut + (128 * (2 * wave + s_in) + j_in) * 32 + 16 * h;
    LAS unsigned char* Xw = lds + wave * X_BYTES;
    LAS f32x2* E = (LAS f32x2*)(lds + LDS_E);
    const f32x16 z16 = {0.f, 0.f, 0.f, 0.f, 0.f, 0.f, 0.f, 0.f, 0.f, 0.f, 0.f, 0.f, 0.f, 0.f, 0.f, 0.f};
    float x0r = 0.f, x0i = 0.f, x1r = 0.f, x1i = 0.f;
#pragma unroll 1
    for (int it = 0; it < 8; ++it) {
        const h8 a = *(const LAS h8*)(urow + it * 512);
        const f32x16 b0 = __builtin_amdgcn_mfma_f32_32x32x16_f16(a, bbf[0], z16, 0, 0, 0), b1 = __builtin_amdgcn_mfma_f32_32x32x16_f16(a, bbf[1], z16, 0, 0, 0);
        const f32x16 b2 = __builtin_amdgcn_mfma_f32_32x32x16_f16(a, bbf[2], z16, 0, 0, 0), b3 = __builtin_amdgcn_mfma_f32_32x32x16_f16(a, bbf[3], z16, 0, 0, 0);
        asm volatile("s_nop 15\n\ts_nop 15\n\ts_nop 15" :: "v"(a));
#pragma unroll
        for (int i = 0; i < 16; ++i) {
            const float n0r = fmaf(A0.x, x0r, fmaf(-A0.y, x0i, b0[i])), n0i = fmaf(A0.x, x0i, fmaf(A0.y, x0r, b2[i])); x0r = n0r; x0i = n0i;
            const float n1r = fmaf(A1.x, x1r, fmaf(-A1.y, x1i, b1[i])), n1i = fmaf(A1.x, x1i, fmaf(A1.y, x1r, b3[i])); x1r = n1r; x1i = n1i; }
    }
    E[(2 * wave + h) * 64 + c] = (f32x2){x0r, x0i}; E[(2 * wave + h) * 64 + 32 + c] = (f32x2){x1r, x1i};
    __syncthreads();
    x0r = 0.f; x0i = 0.f; x1r = 0.f; x1i = 0.f;
    for (int kk = 0; kk < 2 * wave + h; ++kk) { const f32x2 e0 = E[kk * 64 + c], e1 = E[kk * 64 + 32 + c];
        const float n0r = A0.z * x0r - A0.w * x0i + e0.x, n0i = A0.z * x0i + A0.w * x0r + e0.y; x0r = n0r; x0i = n0i;
        const float n1r = A1.z * x1r - A1.w * x1i + e1.x, n1i = A1.z * x1i + A1.w * x1r + e1.y; x1r = n1r; x1i = n1i; }
    const pg8::rsrc_t ry = pg8::mkrsrc(YS + (size_t)(b * SSM_G + g) * SEQ * 16, (size_t)SEQ * 32);
    const unsigned yl = (unsigned)((128 * (2 * wave + (lane >> 5)) + ((lane & 31) >> 1)) * 32 + (lane & 1) * 16);
    h8 dmf;
#pragma unroll
    for (int j = 0; j < 8; ++j) dmf[j] = (q4 < 2 && 8 * q4 + j == c16) ? (half_t)(dsk / isc) : (half_t)0.f;
    LAS unsigned char* xu = Xw + (16 * s_in + j_in) * XROW + 256 + 16 * h;
#pragma unroll 1
    for (int it = 0; it < 8; ++it) {
        const h8 a = *(const LAS h8*)(urow + it * 512);
        const f32x16 b0 = __builtin_amdgcn_mfma_f32_32x32x16_f16(a, bbf[0], z16, 0, 0, 0), b1 = __builtin_amdgcn_mfma_f32_32x32x16_f16(a, bbf[1], z16, 0, 0, 0);
        const f32x16 b2 = __builtin_amdgcn_mfma_f32_32x32x16_f16(a, bbf[2], z16, 0, 0, 0), b3 = __builtin_amdgcn_mfma_f32_32x32x16_f16(a, bbf[3], z16, 0, 0, 0);
        asm volatile("s_nop 15\n\ts_nop 15\n\ts_nop 15" :: "v"(a));
        *(LAS h8*)xu = a;
#pragma unroll
        for (int i = 0; i < 16; ++i) {
            const float n0r = fmaf(A0.x, x0r, fmaf(-A0.y, x0i, b0[i])), n0i = fmaf(A0.x, x0i, fmaf(A0.y, x0r, b2[i])); x0r = n0r; x0i = n0i;
            const float n1r = fmaf(A1.x, x1r, fmaf(-A1.y, x1i, b1[i])), n1i = fmaf(A1.x, x1i, fmaf(A1.y, x1r, b3[i])); x1r = n1r; x1i = n1i;
            *(LAS unsigned*)(Xw + (16 * h + i) * XROW + 4 * c) = pk2h(x0r, x0i); *(LAS unsigned*)(Xw + (16 * h + i) * XROW + 128 + 4 * c) = pk2h(x1r, x1i); }
        asm volatile("s_waitcnt lgkmcnt(0)" ::: "memory");
        f32x4 y0 = {0.f, 0.f, 0.f, 0.f}, y1 = {0.f, 0.f, 0.f, 0.f};
#pragma unroll
        for (int ks = 0; ks < 4; ++ks) {
            const h8 f0 = *(const LAS h8*)(Xw + c16 * XROW + (32 * ks + 8 * q4) * 2), f1 = *(const LAS h8*)(Xw + (16 + c16) * XROW + (32 * ks + 8 * q4) * 2);
            y0 = __builtin_amdgcn_mfma_f32_16x16x32_f16(f0, cmf[ks], y0, 0, 0, 0); y1 = __builtin_amdgcn_mfma_f32_16x16x32_f16(f1, cmf[ks], y1, 0, 0, 0); asm volatile("" :: "v"(f0), "v"(f1)); }
        {
            const h8 f0 = *(const LAS h8*)(Xw + c16 * XROW + 256 + 16 * (q4 & 1)), f1 = *(const LAS h8*)(Xw + (16 + c16) * XROW + 256 + 16 * (q4 & 1));
            y0 = __builtin_amdgcn_mfma_f32_16x16x32_f16(f0, dmf, y0, 0, 0, 0); y1 = __builtin_amdgcn_mfma_f32_16x16x32_f16(f1, dmf, y1, 0, 0, 0); asm volatile("s_nop 15\n\ts_nop 15" :: "v"(f0), "v"(f1)); }
        asm volatile("s_waitcnt lgkmcnt(0)" ::: "memory");
#pragma unroll
        for (int e = 0; e < 4; ++e) { *(LAS half_t*)(Xw + (4 * q4 + e) * 32 + c16 * 2) = (half_t)gelu_tanh_f(y0[e] * isc); *(LAS half_t*)(Xw + (16 + 4 * q4 + e) * 32 + c16 * 2) = (half_t)gelu_tanh_f(y1[e] * isc); }
        asm volatile("s_waitcnt lgkmcnt(0)" ::: "memory");
        pg8::bst128(*(const LAS u32x4*)(Xw + lane * 16), ry, yl, (unsigned)(it * 16 * 32));
        asm volatile("s_waitcnt lgkmcnt(0)" ::: "memory");
    }
    __syncthreads();
}
}

namespace attn {
constexpr int D = 128, NW = 8, QBLK = 32, KVBLK = 64, QB = NW * QBLK;
constexpr float SCALE = 0.08838834764831845f, THR = 8.f;
constexpr int SHM_V = KVBLK * D * 2, SHM_K = KVBLK * D * 2;
constexpr int OST_OFF = 2 * SHM_V + 2 * SHM_K + NW * 64 * 4, OST_ROW = 272, OST_WAVE = 32 * OST_ROW;
constexpr int LDS_BYTES_ATT = OST_OFF + NW * OST_WAVE;
typedef short s16x4 __attribute__((ext_vector_type(4)));
#define KSWZ(row, colB) ((row) * 256 + ((colB) ^ (((row) & 7) << 4)))
#define SBAR() __builtin_amdgcn_sched_barrier(0)
#define MFMA_SRC_GUARD2(x, y) asm volatile("s_nop 15\n\ts_nop 15" :: "v"(x), "v"(y))
__device__ __forceinline__ int v_st(int k, int c) { const int kk = (k & ~0xC) | ((k & 4) << 1) | ((k & 8) >> 1); return ((kk >> 3) * 4 + (c >> 5)) * 512 + ((kk & 7) * 32 + (c & 31)) * 2; }
__device__ __forceinline__ int v_rd_base(int lane) { return ((lane & 3) << 3) | (((lane >> 2) & 3) << 6) | (((lane >> 4) & 1) << 5) | (((lane >> 5) & 1) << 8); }
constexpr int v_rd_off(int d0, int ks, int half) { return d0 * 512 + ks * 4096 + half * 2048; }
__device__ __forceinline__ int crow(int r, int hi) { return (r & 3) + 8 * (r >> 2) + 4 * hi; }
__device__ __forceinline__ h8 load8(const half_t* p) { return *reinterpret_cast<const h8*>(p); }
__device__ __forceinline__ void mask_tile(f32x16& p0, f32x16& p1, int dq) {
    const float NEG = -__builtin_inff();
#pragma unroll
    for (int r = 0; r < 16; ++r) { const int c = (r & 3) + 8 * (r >> 2); if (dq - c < 0) p0[r] = NEG; if (dq - c - 32 < 0) p1[r] = NEG; }
}
__device__ __forceinline__ void partialSM(f32x16& p0, f32x16& p1, float& m_reg, float& mn, float& alpha, bool sel) {
    float pmax = p0[0]; for (int r = 1; r < 16; ++r) pmax = fmaxf(pmax, p0[r]); for (int r = 0; r < 16; ++r) pmax = fmaxf(pmax, p1[r]);
    { auto rr = __builtin_amdgcn_permlane32_swap(__float_as_uint(pmax), __float_as_uint(pmax), false, false);
      pmax = fmaxf(__uint_as_float(rr[0]), __uint_as_float(rr[1])); }
    pmax = sel ? pmax : -__builtin_inff();
    constexpr float C2 = 1.4426950408889634f * SCALE;
    if (__builtin_expect(__all((pmax - m_reg) * SCALE <= THR), 1)) { mn = m_reg; alpha = 1.f; }
    else { mn = fmaxf(m_reg, pmax); alpha = __builtin_amdgcn_exp2f((m_reg - mn) * C2); m_reg = mn; }
    const float mnL = sel ? -mn * C2 : -__builtin_inff();
    for (int r = 0; r < 16; ++r) p0[r] = fmaf(p0[r], C2, mnL); for (int r = 0; r < 16; ++r) p1[r] = fmaf(p1[r], C2, mnL);
    for (int r = 0; r < 16; ++r) p0[r] = __builtin_amdgcn_exp2f(p0[r]);
}
__device__ __forceinline__ void finishSM(f32x16& p0, f32x16& p1, float alpha, float& l_reg, h8& pa0, h8& pa1, h8& pa2, h8& pa3) {
    for (int r = 0; r < 16; ++r) p1[r] = __builtin_amdgcn_exp2f(p1[r]);
    float ps = 0; for (int r = 0; r < 16; ++r) ps += p0[r]; for (int r = 0; r < 16; ++r) ps += p1[r];
    { auto rr = __builtin_amdgcn_permlane32_swap(__float_as_uint(ps), __float_as_uint(ps), false, false);
      ps = __uint_as_float(rr[0]) + __uint_as_float(rr[1]); }
    l_reg = l_reg * alpha + ps;
#define PK4(P, B_, OUT) do { unsigned a0 = pk2h(P[B_+0], P[B_+1]), a1 = pk2h(P[B_+2], P[B_+3]);                          \
        unsigned b0 = pk2h(P[B_+4], P[B_+5]), b1 = pk2h(P[B_+6], P[B_+7]);                                             \
        auto r0 = __builtin_amdgcn_permlane32_swap(a0, b0, false, false); auto r1 = __builtin_amdgcn_permlane32_swap(a1, b1, false, false); \
        u32x4 w = {r0[0], r1[0], r0[1], r1[1]}; OUT = __builtin_bit_cast(h8, w); } while (0)
    PK4(p0, 0, pa0); PK4(p0, 8, pa1); PK4(p1, 0, pa2); PK4(p1, 8, pa3);
#undef PK4
}
template <int KB>
__device__ __forceinline__ void qkt(f32x16& p0, f32x16& p1, const char* K_lds, int r32, int hi, const h8* qr) {
    p0 = f32x16{}; p1 = f32x16{}; asm volatile("" : "+v"(p0), "+v"(p1));
    const char* kb[4];
#pragma unroll
    for (int dd = 0; dd < 4; ++dd) kb[dd] = K_lds + KB * SHM_K + KSWZ(r32, (dd * 16 + hi * 8) * 2);
    h8 b0, b1;
#pragma unroll
    for (int d0 = 0; d0 < 8; ++d0) { const char* a = kb[d0 & 3] + (d0 >> 2) * 128;
        b0 = *reinterpret_cast<const h8*>(a);
        b1 = *reinterpret_cast<const h8*>(a + 32 * 256);
        p0 = __builtin_amdgcn_mfma_f32_32x32x16_f16(b0, qr[d0], p0, 0, 0, 0);
        p1 = __builtin_amdgcn_mfma_f32_32x32x16_f16(b1, qr[d0], p1, 0, 0, 0); }
    MFMA_SRC_GUARD2(b0, b1);
}
template <int VB>
__device__ __forceinline__ void pv_tile(f32x16* o, int vb0, h8 pa0, h8 pa1, h8 pa2, h8 pa3) {
#define TRRD(dst, off) asm volatile("ds_read_b64_tr_b16 %0, %1 offset:%2" : "=&v"(dst) : "v"(vb0), "i"(off) : "memory")
#define MKB(l, h) __builtin_bit_cast(h8, (short __attribute__((ext_vector_type(8)))){l[0], l[1], l[2], l[3], h[0], h[1], h[2], h[3]})
#define PV_D0(d0) do { s16x4 l0, l1, l2, l3, h0, h1, h2, h3; constexpr int b_ = VB * SHM_V + v_rd_off(d0, 0, 0);   \
        TRRD(l0, b_); TRRD(h0, b_ + 2048); TRRD(l1, b_ + 4096); TRRD(h1, b_ + 6144); TRRD(l2, b_ + 8192); TRRD(h2, b_ + 10240); TRRD(l3, b_ + 12288); TRRD(h3, b_ + 14336); \
        asm volatile("s_waitcnt lgkmcnt(0)" ::: "memory"); SBAR();                                                   \
        o[d0] = __builtin_amdgcn_mfma_f32_32x32x16_f16(pa0, MKB(l0, h0), o[d0], 0, 0, 0);   \
        o[d0] = __builtin_amdgcn_mfma_f32_32x32x16_f16(pa1, MKB(l1, h1), o[d0], 0, 0, 0);   \
        o[d0] = __builtin_amdgcn_mfma_f32_32x32x16_f16(pa2, MKB(l2, h2), o[d0], 0, 0, 0);   \
        o[d0] = __builtin_amdgcn_mfma_f32_32x32x16_f16(pa3, MKB(l3, h3), o[d0], 0, 0, 0);   \
        if ((d0) == 3) asm volatile("s_nop 15\n\ts_nop 15" :: "v"(l2), "v"(h2), "v"(l3), "v"(h3), "v"(pa0), "v"(pa1), "v"(pa2), "v"(pa3)); } while (0)
    PV_D0(0); PV_D0(1); PV_D0(2); PV_D0(3);
#undef PV_D0
#undef MKB
#undef TRRD
}

struct BlockRef { const half_t* Q; const half_t* K; const half_t* V; const float* KM; const half_t* ZA; half_t* O; int P0; };
struct Seam { h8 qr[8]; h8 st_v0, st_v1, st_k0, st_k1; };
#define HEADRS(p) pg8::mkrsrc((p), (size_t)SEQ * D * 2)
#define BLD8(rs, voff, soff) __builtin_bit_cast(h8, pg8::bld128((rs), (voff), (unsigned)(soff)))
#define VMW() asm volatile("s_waitcnt vmcnt(0)" ::: "memory")
#define VMWN(n) asm volatile("s_waitcnt vmcnt(%0)" :: "i"(n) : "memory")
#define SLOAD_H(Kp, Vp, k0) do { const pg8::rsrc_t rk_ = HEADRS(Kp), rv_ = HEADRS(Vp);                                           \
                         S.st_v0 = BLD8(rv_, lkv, (k0) * (D * 2)); S.st_v1 = BLD8(rv_, lkv, ((k0) + 32) * (D * 2));              \
                         S.st_k0 = BLD8(rk_, lkv, (k0) * (D * 2)); S.st_k1 = BLD8(rk_, lkv, ((k0) + 32) * (D * 2)); } while (0)
#define SWRITE_HK(bf) do { *(h8*)(K_lds + (bf) * SHM_K + kws) = S.st_k0; *(h8*)(K_lds + (bf) * SHM_K + kws + 32 * 256) = S.st_k1; } while (0)
#define SWRITE_HV(bf) do { *(h8*)(V_lds + (bf) * SHM_V + vst0) = S.st_v0; *(h8*)(V_lds + (bf) * SHM_V + vst1) = S.st_v1; } while (0)
#define SWRITE_H(bf) do { SWRITE_HV(bf); SWRITE_HK(bf); } while (0)
__device__ __forceinline__ void prime(const BlockRef& cur, char* lds, Seam& S, int tid) {
    const int wid = __builtin_amdgcn_readfirstlane(tid >> 6), lane = tid & 63, r32 = lane & 31, hi = lane >> 5;
    const int sr = tid >> 4, sc = (tid & 15) * 8, kws = KSWZ(sr, sc * 2); char* K_lds = lds + 2 * SHM_V;
    const unsigned lkv = (unsigned)(sr * D + sc) * 2u, lq = (unsigned)((wid * QBLK + r32) * D + hi * 8) * 2u;
    { const pg8::rsrc_t rq_ = pg8::mkrsrc(cur.Q, (size_t)QB * D * 2);
#pragma unroll
      for (int d0 = 0; d0 < 8; ++d0) S.qr[d0] = BLD8(rq_, lq, d0 * 32); }
    SLOAD_H(cur.K, cur.V, 0); VMW(); SWRITE_HK(0);
    __syncthreads();
}
__device__ __forceinline__ unsigned moba_select(const float* KM, const h8* qr, int own, int r32, int hi) {
    f32x16 g = f32x16{}; asm volatile("" : "+v"(g));
    const int jb = r32 & 7; const bool lo_part = (r32 & 8) != 0, live = r32 < 16;
#pragma unroll
    for (int d0 = 0; d0 < 8; ++d0) {
        h8 a = {0, 0, 0, 0, 0, 0, 0, 0};
        if (live) { const float* p = KM + jb * D + d0 * 16 + hi * 8;
            const f32x4 x0 = *(const f32x4*)p + *(const f32x4*)(p + pg8::KMEAN_PART), x1 = *(const f32x4*)(p + 4) + *(const f32x4*)(p + 4 + pg8::KMEAN_PART);
#pragma unroll
            for (int e = 0; e < 4; ++e) { const half_t h0 = (half_t)x0[e], h1 = (half_t)x1[e]; a[e] = lo_part ? (half_t)(x0[e] - (float)h0) : h0; a[4 + e] = lo_part ? (half_t)(x1[e] - (float)h1) : h1; } }
        g = __builtin_amdgcn_mfma_f32_32x32x16_f16(a, qr[d0], g, 0, 0, 0);
        asm volatile("s_nop 7" :: "v"(a));
    }
    float gt[8];
#pragma unroll
    for (int j = 0; j < 4; ++j) { const float x = g[j] + g[4 + j];
        auto rr = __builtin_amdgcn_permlane32_swap(__float_as_uint(x), __float_as_uint(x), false, false);
        gt[j] = __uint_as_float(rr[0]); gt[4 + j] = __uint_as_float(rr[1]); }
    unsigned sel = 1u << own;
#pragma unroll
    for (int j = 0; j < 7; ++j) { int rank = 0;
#pragma unroll
        for (int k = 0; k < 7; ++k) if (k != j) rank += (k < own && (gt[k] > gt[j] || (gt[k] == gt[j] && k < j))) ? 1 : 0;
        if (j < own && rank < TOPK) sel |= 1u << j; }
    return sel;
}
__device__ __forceinline__ void block(const BlockRef& cur, const BlockRef& nxt, char* lds, Seam& S, int tid) {
    const int wid = __builtin_amdgcn_readfirstlane(tid >> 6), lane = tid & 63, r32 = lane & 31, hi = lane >> 5;
    const int own = cur.P0 / QB, NT = 4 * (own + 1);
    const int qlo = cur.P0 + wid * QBLK, qm = qlo + r32 - 4 * hi;
    char* V_lds = lds; char* K_lds = lds + 2 * SHM_V;
    float* ws = (float*)(lds + 2 * SHM_V + 2 * SHM_K) + wid * 64; float* li_l = ws, * al_l = ws + 32;
    float m_reg = -1e30f, l_reg = 0; f32x16 o[4] = {};
    const int sr = tid >> 4, sc = (tid & 15) * 8, vst0 = v_st(sr, sc), vst1 = v_st(32 + sr, sc), kws = KSWZ(sr, sc * 2);
    const int vb0 = (int)(uintptr_t)V_lds + v_rd_base(lane);
    const unsigned lkv = (unsigned)(sr * D + sc) * 2u, lq = (unsigned)((wid * QBLK + r32) * D + hi * 8) * 2u;
    const half_t* Kh = cur.K; const half_t* Vh = cur.V;
    const unsigned selm = moba_select(cur.KM, S.qr, own, r32, hi);
#define RESC(a) do { if (__any((a) < 1.f)) { if (hi == 0) al_l[r32] = (a); asm volatile("s_waitcnt lgkmcnt(0)" ::: "memory");              \
                     for (int d_ = 0; d_ < 4; ++d_) for (int r = 0; r < 16; ++r) o[d_][r] *= al_l[crow(r, hi)]; } } while (0)
#define KBASE(t) ((t) * KVBLK)
#define SELT(t) (((selm >> ((t) >> 2)) & 1u) != 0u)
#define MASKT(P0_, P1_, t) do { const int kb_ = KBASE(t); if (kb_ + KVBLK - 1 > qlo) mask_tile(P0_, P1_, qm - kb_); } while (0)
    constexpr int NQL = 8;
#define SEAM_K0() do { VMWN(NQL); SWRITE_HK(0); SBAR(); } while (0)
    f32x16 pA0, pA1, pB0, pB1; float mnA, mnB, alA, alB; h8 pa0, pa1, pa2, pa3;
    SWRITE_HV(0); SBAR();
    if (NT > 1) { SLOAD_H(Kh, Vh, KBASE(1)); }
    SBAR(); qkt<0>(pA0, pA1, K_lds, r32, hi, S.qr);
    MASKT(pA0, pA1, 0); partialSM(pA0, pA1, m_reg, mnA, alA, SELT(0));
    if (NT > 1) { VMW(); SWRITE_H(1); }
    __syncthreads();
#define HALF_STEP(PX0, PX1, mnX, alX, PY0, PY1, alY, t, KB, VB, SB) do {                                                      \
        SBAR(); qkt<KB>(PX0, PX1, K_lds, r32, hi, S.qr);                                                                      \
        finishSM(PY0, PY1, alY, l_reg, pa0, pa1, pa2, pa3); SBAR();                                                           \
        if ((t) + 1 < NT) { SLOAD_H(Kh, Vh, KBASE((t) + 1)); SBAR(); }                                                        \
        pv_tile<VB>(o, vb0, pa0, pa1, pa2, pa3); MASKT(PX0, PX1, (t)); partialSM(PX0, PX1, m_reg, mnX, alX, SELT(t));        \
        __syncthreads();                                                                                                      \
        if ((t) + 1 < NT) { VMW(); SWRITE_H(SB); }                                                                            \
        RESC(alX); __syncthreads(); } while (0)
    for (int t = 1; t + 1 < NT; t += 2) {
        HALF_STEP(pB0, pB1, mnB, alB, pA0, pA1, alA, t, 1, 0, 0);
        HALF_STEP(pA0, pA1, mnA, alA, pB0, pB1, alB, t + 1, 0, 1, 1);
    }
    SBAR(); qkt<1>(pB0, pB1, K_lds, r32, hi, S.qr); SBAR();
    SLOAD_H(nxt.K, nxt.V, 0); SBAR();
    { const pg8::rsrc_t rq_ = pg8::mkrsrc(nxt.Q, (size_t)QB * D * 2);
#pragma unroll
      for (int d0 = 0; d0 < 8; ++d0) S.qr[d0] = BLD8(rq_, lq, d0 * 32); }
    SBAR();
    finishSM(pA0, pA1, alA, l_reg, pa0, pa1, pa2, pa3); SBAR();
    pv_tile<0>(o, vb0, pa0, pa1, pa2, pa3);
    MASKT(pB0, pB1, NT - 1); partialSM(pB0, pB1, m_reg, mnB, alB, true); __syncthreads(); RESC(alB);
    finishSM(pB0, pB1, alB, l_reg, pa0, pa1, pa2, pa3); SBAR(); pv_tile<1>(o, vb0, pa0, pa1, pa2, pa3);
    SBAR(); SEAM_K0();
    if (hi == 0) li_l[r32] = l_reg; asm volatile("s_waitcnt lgkmcnt(0)" ::: "memory");
    float rli[16];
#pragma unroll
    for (int r = 0; r < 16; ++r) rli[r] = __builtin_amdgcn_rcpf(li_l[crow(r, hi)]);
    {
        const pg8::rsrc_t rz = pg8::mkrsrc(cur.ZA, (size_t)QB * ATT_W * 2), ro = pg8::mkrsrc(cur.O, (size_t)QB * BR_K * 2);
        const unsigned vz = (unsigned)((wid * QBLK + (lane >> 4)) * ATT_W + (lane & 15) * 8) * 2u, vo = (unsigned)((wid * QBLK + (lane >> 4)) * BR_K + (lane & 15) * 8) * 2u;
        u32x4 z[8];
#pragma unroll
        for (int i = 0; i < 8; ++i) z[i] = pg8::bld128(rz, vz, (unsigned)(i * 4 * ATT_W) * 2u);
        LAS unsigned char* ost = (LAS unsigned char*)(uintptr_t)(unsigned)(uintptr_t)(lds + OST_OFF) + wid * OST_WAVE;
        LAS unsigned char* ow = ost + 4 * hi * OST_ROW + r32 * 2;
#pragma unroll
        for (int r = 0; r < 16; ++r) { const int rowc = (r & 3) + 8 * (r >> 2);
#pragma unroll
            for (int d0 = 0; d0 < 4; ++d0) *(LAS half_t*)(ow + rowc * OST_ROW + d0 * 64) = (half_t)(o[d0][r] * rli[r]); }
        asm volatile("s_waitcnt lgkmcnt(0)" ::: "memory");
        const LAS unsigned char* orp = ost + (lane >> 4) * OST_ROW + (lane & 15) * 16;
#pragma unroll
        for (int i = 0; i < 8; ++i) { f32x4 a0, a1, z0, z1; unpk8h(*(const LAS u32x4*)(orp + i * 4 * OST_ROW), a0, a1); unpk8h(z[i], z0, z1);
            pg8::bst128(pk8h(a0 * z0, a1 * z1), ro, vo, (unsigned)(i * 4 * BR_K) * 2u); }
    }
    __syncthreads();
#undef RESC
#undef KBASE
#undef SELT
#undef MASKT
#undef SEAM_K0
#undef HALF_STEP
}
#undef HEADRS
#undef BLD8
#undef VMW
#undef VMWN
#undef SLOAD_H
#undef SWRITE_HK
#undef SWRITE_HV
#undef SWRITE_H

__device__ __forceinline__ BlockRef make_ref(int L, int pass, const unsigned char* ws) {
    const int bh = L >> 2, x = L & 3, qb = pass ? (NBLK - 1 - x) : x, b = bh / NH, h = bh % NH;
    BlockRef r; const size_t hb = (size_t)bh * SEQ * D;
    r.Q = (const half_t*)(ws + WS_Q) + hb + (size_t)qb * QB * D; r.K = (const half_t*)(ws + WS_K) + hb; r.V = (const half_t*)(ws + WS_V) + hb;
    r.KM = (const float*)(ws + WS_KMEAN) + (size_t)bh * NBLK * D;
    const size_t m0 = (size_t)b * SEQ + (size_t)qb * QB;
    r.ZA = (const half_t*)(ws + WS_ZA) + m0 * ATT_W + h * D; r.O = (half_t*)(ws + WS_OSA) + m0 * BR_K + SSM_W + h * D; r.P0 = qb * QB;
    return r;
}
__device__ __forceinline__ void phase(char* lds, const unsigned char* ws, int vcu, int G) {
    int tid_ = threadIdx.x; asm volatile("" : "+v"(tid_));
    const int total = BATCH * NH * 4;
#ifdef EXP_ATT_SCATTER
    int L = blockIdx.x; if (L >= total) return;
#else
    int L = vcu; if (L >= total) return;
#endif
    int pass = 0; BlockRef cur = make_ref(L, 0, ws);
    Seam S; prime(cur, lds, S, tid_);
    for (;;) {
        const bool more_pass = pass == 0, more_item = L + G < total, last = !more_pass && !more_item;
        int passn = pass + 1, Ln = L; if (!more_pass) { passn = 0; Ln = more_item ? L + G : L; }
        const BlockRef nxt = last ? cur : make_ref(Ln, passn, ws);
        block(cur, nxt, lds, S, tid_);
        if (last) break;
        cur = nxt; pass = passn; L = Ln;
    }
}
}
static_assert(attn::LDS_BYTES_ATT <= RING_BYTES && s5::LDS_BYTES_S5 <= RING_BYTES && pg8::STAGE_BYTES <= RING_BYTES, "phase scratch must stay below the LDS control words");

struct Frame {
    LAS unsigned char* lds; volatile LAS unsigned* MISC; gu32* ctl;
    int tid, lane, wave, vcu, G;
};

__device__ __forceinline__ float wave_sum(float v) {
#pragma unroll
    for (int o = 1; o < 64; o <<= 1) v += __shfl_xor(v, o);
    return v;
}
__host__ __device__ __forceinline__ int bt_slot(int c, bool natural) { return natural ? c : (16 * ((c >> 2) & 1) + 4 * (c >> 3) + (c & 3)); }

__device__ __forceinline__ void p0_transpose_item(const float* W, int N, half_t* WT, int ldk, int koff, bool rope_cols, LAS float* scr, int item, int lane) {
    const bool bf = G1_BF16 && rope_cols;
    const int nblk = N / 32, kb = item / nblk, nb = item % nblk, k0 = 64 * kb, n0 = 32 * nb;
    f32x4 t[8];
#pragma unroll
    for (int i = 0; i < 8; ++i) t[i] = *(const f32x4*)(W + (size_t)(k0 + 8 * i + (lane >> 3)) * N + n0 + 4 * (lane & 7));
#pragma unroll
    for (int i = 0; i < 8; ++i) { LAS float* d = scr + (8 * i + (lane >> 3)) * 33 + 4 * (lane & 7); d[0] = t[i].x; d[1] = t[i].y; d[2] = t[i].z; d[3] = t[i].w; }
    LDS_WAIT(); asm volatile("" ::: "memory");
    const bool natural = rope_cols && n0 >= 2048 && n0 < 6144 && (n0 & 127) == 0;
    const pg8::rsrc_t rw = pg8::mkrsrc(WT, (size_t)N * ldk * 2);
    const int c = lane & 7;
#pragma unroll
    for (int j = 0; j < 4; ++j) { const int n = (lane >> 3) + 8 * j; const LAS float* s = scr + (8 * c) * 33 + n;
        u32x4 o; if (bf) { o.x = pk2bf(s[0 * 33], s[1 * 33]); o.y = pk2bf(s[2 * 33], s[3 * 33]); o.z = pk2bf(s[4 * 33], s[5 * 33]); o.w = pk2bf(s[6 * 33], s[7 * 33]); }
        else { o.x = pk2h(s[0 * 33], s[1 * 33]); o.y = pk2h(s[2 * 33], s[3 * 33]); o.z = pk2h(s[4 * 33], s[5 * 33]); o.w = pk2h(s[6 * 33], s[7 * 33]); }
        pg8::bst128(o, rw, (unsigned)(((size_t)(n0 + bt_slot(n, natural)) * ldk + koff + k0 + 8 * c) * 2), 0u); }
    LDS_WAIT(); asm volatile("" ::: "memory");
}

struct Args { const float* in[17]; float* out; unsigned char* ws; int ph_lo, ph_hi; };

__device__ __forceinline__ void norm_row_to_h(const float* xrow, const float* g, half_t* orow, int lane) {
    f32x4 v[8]; float s = 0.f;
#pragma unroll
    for (int j = 0; j < 8; ++j) { v[j] = *(const f32x4*)(xrow + 4 * lane + 256 * j); s += (v[j].x * v[j].x + v[j].y * v[j].y) + (v[j].z * v[j].z + v[j].w * v[j].w); }
    const float r = rsqrtf(wave_sum(s) * (1.f / D_MODEL) + EPS);
#pragma unroll
    for (int j = 0; j < 8; ++j) { const f32x4 gg = *(const f32x4*)(g + 4 * lane + 256 * j);
        u32x2 o = {pk2x(v[j].x * r * gg.x, v[j].y * r * gg.y), pk2x(v[j].z * r * gg.z, v[j].w * r * gg.w)};
        __hip_atomic_store((unsigned long long*)(orow + 4 * lane + 256 * j), __builtin_bit_cast(unsigned long long, o), RLX_AGENT); }
}
__device__ __forceinline__ void resnorm_row(const float* xi, const half_t* orow, const float* gpost, float* xo, const float* gpre, half_t* xn, int lane) {
    f32x4 v[8]; float s = 0.f;
#pragma unroll
    for (int j = 0; j < 8; ++j) { const h4 hv = *(const h4*)(orow + 4 * lane + 256 * j); v[j] = (f32x4){(float)hv[0], (float)hv[1], (float)hv[2], (float)hv[3]}; s += (v[j].x * v[j].x + v[j].y * v[j].y) + (v[j].z * v[j].z + v[j].w * v[j].w); }
    const float r = rsqrtf(wave_sum(s) * (1.f / D_MODEL) + EPS); float s2 = 0.f;
#pragma unroll
    for (int j = 0; j < 8; ++j) { const f32x4 gg = *(const f32x4*)(gpost + 4 * lane + 256 * j), xx = *(const f32x4*)(xi + 4 * lane + 256 * j);
        v[j] = xx + v[j] * r * gg; pg8::bst128(__builtin_bit_cast(u32x4, v[j]), pg8::mkrsrc(xo, (size_t)D_MODEL * 4), (unsigned)(4 * lane + 256 * j) * 4u, 0u); s2 += (v[j].x * v[j].x + v[j].y * v[j].y) + (v[j].z * v[j].z + v[j].w * v[j].w); }
    if (xn) { const float r2 = rsqrtf(wave_sum(s2) * (1.f / D_MODEL) + EPS);
#pragma unroll
        for (int j = 0; j < 8; ++j) { const f32x4 gg = *(const f32x4*)(gpre + 4 * lane + 256 * j);
            u32x2 o = {pk2x(v[j].x * r2 * gg.x, v[j].y * r2 * gg.y), pk2x(v[j].z * r2 * gg.z, v[j].w * r2 * gg.w)};
            __hip_atomic_store((unsigned long long*)(xn + 4 * lane + 256 * j), __builtin_bit_cast(unsigned long long, o), RLX_AGENT); } }
}

#ifndef W1_SPLIT
#define W1_SPLIT 4096
#endif
__device__ __forceinline__ void p0_weights(LAS unsigned char* lds, const Args& a, int l, int worker, int nworkers, int it_lo, int it_hi) {
    unsigned char* ws = a.ws;
    int t_ = threadIdx.x; asm volatile("" : "+v"(t_)); const int lane = t_ & 63, wave = __builtin_amdgcn_readfirstlane(t_ >> 6);
    LAS float* scr = (LAS float*)(lds + RING_OFF + wave * 16384);
    constexpr int I_IN = (D_MODEL / 64) * (IN_W / 32), I_GLU = (SSM_W / 64) * (SSM_W / 32), I_BS = (SSM_W / 64) * (D_MODEL / 32), I_BA = (ATT_W / 64) * (D_MODEL / 32), I_OUT = (D_MODEL / 64) * (D_MODEL / 32);
    constexpr int I_LAYER = I_IN + I_GLU + I_BS + I_BA + I_OUT;
    for (int it = it_lo + worker; it < (it_hi < I_LAYER ? it_hi : I_LAYER); it += nworkers) {
        int r = it;
        if (r < I_IN) { p0_transpose_item(a.in[3] + (size_t)l * D_MODEL * IN_W, IN_W, (half_t*)(ws + WS_WIN + l * WIN_STRIDE), D_MODEL, 0, true, scr, r, lane); continue; } r -= I_IN;
        if (r < I_GLU) { p0_transpose_item(a.in[12] + (size_t)l * SSM_W * SSM_W, SSM_W, (half_t*)(ws + WS_WGLU + l * WGLU_STRIDE), SSM_W, 0, false, scr, r, lane); continue; } r -= I_GLU;
        if (r < I_BS) { p0_transpose_item(a.in[14] + (size_t)l * SSM_W * D_MODEL, D_MODEL, (half_t*)(ws + WS_WBR + l * WBR_STRIDE), BR_K, 0, false, scr, r, lane); continue; } r -= I_BS;
        if (r < I_BA) { p0_transpose_item(a.in[15] + (size_t)l * ATT_W * D_MODEL, D_MODEL, (half_t*)(ws + WS_WBR + l * WBR_STRIDE), BR_K, SSM_W, false, scr, r, lane); continue; } r -= I_BA;
        p0_transpose_item(a.in[16] + (size_t)l * D_MODEL * D_MODEL, D_MODEL, (half_t*)(ws + WS_WOUT + l * WOUT_STRIDE), D_MODEL, 0, false, scr, r, lane);
    }
}
__device__ __forceinline__ void p0_prologue(Frame& F0, const Args& a) {
    unsigned char* ws = a.ws;
    Frame F = F0; { int t_ = threadIdx.x; asm volatile("" : "+v"(t_)); F.tid = t_; F.lane = t_ & 63; F.wave = __builtin_amdgcn_readfirstlane(t_ >> 6); }
    const int gw = F.vcu * NWAVES + F.wave, NGW = F.G * NWAVES;
    p0_weights(F.lds, a, 0, gw, NGW, 0, 1 << 30);
    p0_weights(F.lds, a, 1, gw, NGW, 0, F.G >= 256 ? W1_SPLIT : (1 << 30));
    const int gt = F.vcu * (NWAVES * 64) + F.tid, NGT = F.G * NWAVES * 64;
    for (int i = gt; i < SEQ * ROT_H; i += NGT) { const int t = i / ROT_H, j = i % ROT_H;
        const float inv_freq = powf(500000.0f, -(float)(2 * j) / (float)ROT), ang = (float)t * inv_freq;
        float* rp = (float*)(ws + WS_ROPE) + (size_t)t * 32; __hip_atomic_store(rp + j, cosf(ang), RLX_AGENT); __hip_atomic_store(rp + 16 + j, sinf(ang), RLX_AGENT); }
    for (int i = gt; i < DEPTH * SSM_G * SSM_P; i += NGT) { const int l = i / (SSM_G * SSM_P), g = (i / SSM_P) % SSM_G, p = i % SSM_P;
        const float lr = a.in[4][i], li = a.in[5][i], ldt = a.in[6][l * SSM_G + g], dt = expf(ldt);
        const float mag = expf(lr * dt), are = mag * cosf(li * dt), aim = mag * sinf(li * dt);
        const float den = lr * lr + li * li, nr = are - 1.f, ni = aim, fre = (nr * lr + ni * li) / den, fim = (ni * lr - nr * li) / den;
        const float sc = exp2f(rintf(-ldt * 1.4426950408889634f));
        unsigned char* s5 = ws + WS_S5 + l * S5_STRIDE;
        float pr = are, pi = aim;
#pragma unroll
        for (int q = 0; q < 7; ++q) { const float nr2 = pr * pr - pi * pi, ni2 = 2.f * pr * pi; pr = nr2; pi = ni2; }
        pg8::bst128(__builtin_bit_cast(u32x4, (f32x4){are, aim, pr, pi}), pg8::mkrsrc(s5 + S5_A, (size_t)SSM_G * SSM_P * 16), (unsigned)(g * SSM_P + p) * 16u, 0u);
        half_t* bb = (half_t*)(s5 + S5_BB) + (size_t)g * 128 * 16; half_t* cm = (half_t*)(s5 + S5_CM) + (size_t)g * 16 * 128;
        const float* bre = a.in[7] + (size_t)i * SSM_GC; const float* bim = a.in[8] + (size_t)i * SSM_GC;
        unsigned bbr[8], bbi[8];
#pragma unroll
        for (int c = 0; c < SSM_GC; c += 2) { const float br0 = bre[c], bi0 = bim[c], br1 = bre[c + 1], bi1 = bim[c + 1];
            bbr[c >> 1] = pk2h((fre * br0 - fim * bi0) * sc, (fre * br1 - fim * bi1) * sc); bbi[c >> 1] = pk2h((fre * bi0 + fim * br0) * sc, (fre * bi1 + fim * br1) * sc); }
        { const pg8::rsrc_t rb = pg8::mkrsrc(bb, (size_t)128 * 16 * 2);
          pg8::bst128((u32x4){bbr[0], bbr[1], bbr[2], bbr[3]}, rb, (unsigned)p * 32u, 0u); pg8::bst128((u32x4){bbr[4], bbr[5], bbr[6], bbr[7]}, rb, (unsigned)p * 32u + 16u, 0u);
          pg8::bst128((u32x4){bbi[0], bbi[1], bbi[2], bbi[3]}, rb, (unsigned)(64 + p) * 32u, 0u); pg8::bst128((u32x4){bbi[4], bbi[5], bbi[6], bbi[7]}, rb, (unsigned)(64 + p) * 32u + 16u, 0u); }
#pragma unroll
        for (int c = 0; c < SSM_GC; ++c) { const size_t ci = ((size_t)(l * SSM_G + g) * SSM_GC + c) * SSM_P + p;
            __hip_atomic_store((unsigned*)(cm + (size_t)c * 128 + 2 * p), pk2h(a.in[9][ci], -a.in[10][ci]), RLX_AGENT); }
    }
    for (int m = gw; m < M; m += NGW) norm_row_to_h(a.in[0] + (size_t)m * D_MODEL, a.in[1], (half_t*)(ws + WS_XN) + (size_t)m * D_MODEL, F.lane);
}

#ifndef REPEAT_MASK
#define REPEAT_MASK 0
#endif
#ifndef S5_USRC
#define S5_USRC WS_U
#endif
#ifndef G1_ALIGN
#define G1_ALIGN true
#endif
#ifndef G1_SP2
#define G1_SP2 true
#endif
constexpr int PH_PER_LAYER = 6, N_PHASES = 1 + DEPTH * PH_PER_LAYER;
__global__ void __launch_bounds__(NWAVES * 64, 2) mk_fwd(Args args) {
    extern __shared__ __attribute__((aligned(16))) unsigned char lds[];
    Frame F;
    F.lds = (LAS unsigned char*)lds; F.MISC = (volatile LAS unsigned*)(F.lds + MISC_OFF);
    F.tid = 0; F.lane = 0; F.wave = 0;
    F.G = gridDim.x; { const int bx = blockIdx.x; F.vcu = (F.G % 8 == 0) ? (bx % 8) * (F.G / 8) + bx / 8 : bx; }
    unsigned char* ws = args.ws;
    F.ctl = (gu32*)(ws + WS_CTL);
#ifdef EXP_ZERO_LDS
    for (int u = threadIdx.x; u < LDSCTL_OFF / 4; u += NWAVES * 64) ((LAS unsigned*)(F.lds))[u] = 0u;
#endif
    for (int u = threadIdx.x; u < (LDS_BYTES - LDSCTL_OFF) / 4; u += NWAVES * 64) ((LAS unsigned*)(F.lds + LDSCTL_OFF))[u] = 0u;
    __syncthreads();
    XcdBarrier bar = xcd_barrier_post((unsigned*)(F.ctl + CW_BAR), F.MISC + 8);
    const int lo = args.ph_lo, hi = args.ph_hi;
#define IN(k) (lo <= (k) && (k) < hi)
#ifdef EXP_SIMPLE_BAR
#define SEAM(k) do { if (IN(k) && IN((k) + 1)) { asm volatile("s_waitcnt vmcnt(0)" ::: "memory"); __syncthreads(); \
      if (threadIdx.x == 0) { unsigned* c_ = (unsigned*)(F.ctl + 2048); const unsigned ep_ = F.MISC[12] + 1u; F.MISC[12] = ep_; \
          __builtin_amdgcn_fence(__ATOMIC_RELEASE, "agent"); asm volatile("s_waitcnt vmcnt(0)" ::: "memory"); \
          __hip_atomic_fetch_add(c_, 1u, __ATOMIC_RELAXED, __HIP_MEMORY_SCOPE_AGENT); \
          while (__hip_atomic_load(c_, __ATOMIC_RELAXED, __HIP_MEMORY_SCOPE_AGENT) < ep_ * gridDim.x) __builtin_amdgcn_s_sleep(2); \
          __builtin_amdgcn_fence(__ATOMIC_ACQUIRE, "agent"); asm volatile("s_waitcnt vmcnt(0)" ::: "memory"); } \
      __syncthreads(); } } while (0)
#else
#define SEAM(k) do { if (IN(k) && IN((k) + 1)) { xcd_barrier(bar); SEAM_DELAY(); } } while (0)
#endif
#ifdef EXP_DELAY
#define SEAM_DELAY() do { __builtin_amdgcn_s_sleep(127); __builtin_amdgcn_s_sleep(127); __builtin_amdgcn_s_sleep(127); } while (0)
#else
#define SEAM_DELAY() do {} while (0)
#endif
#ifdef EXP_SELF_POISON
    if (IN(0)) { const size_t gt_ = (size_t)blockIdx.x * (NWAVES * 64) + threadIdx.x, ngt_ = (size_t)gridDim.x * NWAVES * 64; u32x4 zz = {0u, 0u, 0u, 0u};
        for (size_t o = gt_ * 16; o < (size_t)(576 - 160) * MiB; o += ngt_ * 16) *(GAS u32x4*)(ws + WS_XN + o) = zz;
        for (size_t o = gt_ * 16; o < (size_t)3 * MiB; o += ngt_ * 16) *(GAS u32x4*)(ws + WS_ROPE + o) = zz;
        xcd_barrier(bar); }
#endif
    if (IN(0)) { p0_prologue(F, args); }
#if REPEAT_MASK & 64
    xcd_barrier(bar); p0_prologue(F, args);
#endif
    SEAM(0);
#pragma unroll 1
    for (int l = 0; l < DEPTH; ++l) {
        const int pb = 1 + l * PH_PER_LAYER;
        half_t* XN = (half_t*)(ws + WS_XN);
        if (IN(pb + 0)) {
            pg8::Gemm g{XN, (const half_t*)(ws + WS_WIN + l * WIN_STRIDE), M, IN_W, D_MODEL}; pg8::StaticOrder S; S.init(M, IN_W, F.G, (int)blockIdx.x);
            pg8::EpiIn E{ws, (float*)(ws + WS_KMEAN), (const float*)(ws + WS_ROPE)};
            pg8::gemm_phase<pg8::EpiIn, pg8::StaticOrder, G1_ALIGN, G1_SP2>(F.lds + RING_OFF, g, S, E);
        }
#if REPEAT_MASK & 1
        xcd_barrier(bar);
        if (IN(pb + 0)) {
            pg8::Gemm g{XN, (const half_t*)(ws + WS_WIN + l * WIN_STRIDE), M, IN_W, D_MODEL}; pg8::StaticOrder S; S.init(M, IN_W, F.G, (int)blockIdx.x);
            pg8::EpiIn E{ws, (float*)(ws + WS_KMEAN), (const float*)(ws + WS_ROPE)};
            pg8::gemm_phase<pg8::EpiIn, pg8::StaticOrder, G1_ALIGN, G1_SP2>(F.lds + RING_OFF, g, S, E);
        }
#endif
        SEAM(pb + 0);
        if (IN(pb + 1)) {
#ifdef EXP_S5_LOOP2
            int nrep_ = 2; asm volatile("" : "+s"(nrep_));
            for (int rep_ = 0; rep_ < nrep_; ++rep_)
#endif
#ifdef EXP_S5_SCATTER
            for (int u = blockIdx.x; u < BATCH * SSM_G; u += F.G) {
#else
            for (int u = F.vcu; u < BATCH * SSM_G; u += F.G) {
#endif
                s5::unit(F.lds + RING_OFF, u / SSM_G, u % SSM_G, (const half_t*)(ws + S5_USRC), (half_t*)(ws + WS_YS), ws + WS_S5 + l * S5_STRIDE, args.in[11] + l * SSM_W, args.in[6] + l * SSM_G);
            }
            attn::phase((char*)lds + RING_OFF, ws, F.vcu, F.G);
        }
#if REPEAT_MASK & 2
        xcd_barrier(bar);
        if (IN(pb + 1)) { for (int u = F.vcu; u < BATCH * SSM_G; u += F.G)
                s5::unit(F.lds + RING_OFF, u / SSM_G, u % SSM_G, (const half_t*)(ws + S5_USRC), (half_t*)(ws + WS_YS), ws + WS_S5 + l * S5_STRIDE, args.in[11] + l * SSM_W, args.in[6] + l * SSM_G); }
#endif
#if REPEAT_MASK & 32
        xcd_barrier(bar);
        if (IN(pb + 1)) { attn::phase((char*)lds + RING_OFF, ws, F.vcu, F.G); }
#endif
        SEAM(pb + 1);
        if (IN(pb + 2)) {
            pg8::Gemm g{(const half_t*)(ws + WS_YS), (const half_t*)(ws + WS_WGLU + l * WGLU_STRIDE), M, SSM_W, SSM_W}; pg8::StaticOrder S; S.init(M, SSM_W, F.G, (int)blockIdx.x);
            pg8::EpiGlu E{(const half_t*)(ws + WS_YS), (const half_t*)(ws + WS_ZS), args.in[13] + l * SSM_W, (half_t*)(ws + WS_OSA)};
            pg8::gemm_phase<pg8::EpiGlu, pg8::StaticOrder, true, true>(F.lds + RING_OFF, g, S, E);
            if (l == 0 && F.G >= 256 && (int)blockIdx.x >= (M / 256) * (SSM_W / 256)) {
                const int nidle = F.G - (M / 256) * (SSM_W / 256); int t2_ = threadIdx.x; asm volatile("" : "+v"(t2_));
                p0_weights(F.lds, args, 1, ((int)blockIdx.x - (M / 256) * (SSM_W / 256)) * NWAVES + __builtin_amdgcn_readfirstlane(t2_ >> 6), nidle * NWAVES, W1_SPLIT, 1 << 30); }
        }
#if REPEAT_MASK & 4
        xcd_barrier(bar);
        if (IN(pb + 2)) {
            pg8::Gemm g{(const half_t*)(ws + WS_YS), (const half_t*)(ws + WS_WGLU + l * WGLU_STRIDE), M, SSM_W, SSM_W}; pg8::StaticOrder S; S.init(M, SSM_W, F.G, (int)blockIdx.x);
            pg8::EpiGlu E{(const half_t*)(ws + WS_YS), (const half_t*)(ws + WS_ZS), args.in[13] + l * SSM_W, (half_t*)(ws + WS_OSA)};
            pg8::gemm_phase<pg8::EpiGlu, pg8::StaticOrder, true, true>(F.lds + RING_OFF, g, S, E);
        }
#endif
        SEAM(pb + 2);
        if (IN(pb + 3)) {
            pg8::Gemm g{(const half_t*)(ws + WS_OSA), (const half_t*)(ws + WS_WBR + l * WBR_STRIDE), M, D_MODEL, BR_K}; pg8::StaticOrder S; S.init(M, D_MODEL, F.G, (int)blockIdx.x);
            pg8::EpiMerge E{(const half_t*)(ws + WS_GS), (const half_t*)(ws + WS_GA), (half_t*)(ws + WS_MG)};
            pg8::gemm_phase<pg8::EpiMerge, pg8::StaticOrder, true, true>(F.lds + RING_OFF, g, S, E);
        }
#if REPEAT_MASK & 8
        xcd_barrier(bar);
        if (IN(pb + 3)) {
            pg8::Gemm g{(const half_t*)(ws + WS_OSA), (const half_t*)(ws + WS_WBR + l * WBR_STRIDE), M, D_MODEL, BR_K}; pg8::StaticOrder S; S.init(M, D_MODEL, F.G, (int)blockIdx.x);
            pg8::EpiMerge E{(const half_t*)(ws + WS_GS), (const half_t*)(ws + WS_GA), (half_t*)(ws + WS_MG)};
            pg8::gemm_phase<pg8::EpiMerge, pg8::StaticOrder, true, true>(F.lds + RING_OFF, g, S, E);
        }
#endif
        SEAM(pb + 3);
        if (IN(pb + 4)) {
            pg8::Gemm g{(const half_t*)(ws + WS_MG), (const half_t*)(ws + WS_WOUT + l * WOUT_STRIDE), M, D_MODEL, D_MODEL}; pg8::StaticOrder S; S.init(M, D_MODEL, F.G, (int)blockIdx.x);
            pg8::EpiOut E{(half_t*)(ws + WS_OUT)};
            pg8::gemm_phase<pg8::EpiOut, pg8::StaticOrder, true, true>(F.lds + RING_OFF, g, S, E);
        }
#if REPEAT_MASK & 16
        xcd_barrier(bar);
        if (IN(pb + 4)) {
            pg8::Gemm g{(const half_t*)(ws + WS_MG), (const half_t*)(ws + WS_WOUT + l * WOUT_STRIDE), M, D_MODEL, D_MODEL}; pg8::StaticOrder S; S.init(M, D_MODEL, F.G, (int)blockIdx.x);
            pg8::EpiOut E{(half_t*)(ws + WS_OUT)};
            pg8::gemm_phase<pg8::EpiOut, pg8::StaticOrder, true, true>(F.lds + RING_OFF, g, S, E);
        }
#endif
        SEAM(pb + 4);
        if (IN(pb + 5)) {
            int t_ = threadIdx.x; asm volatile("" : "+v"(t_)); const int lane_ = t_ & 63, wave_ = __builtin_amdgcn_readfirstlane(t_ >> 6);
            const int gw = F.vcu * NWAVES + wave_, NGW = F.G * NWAVES;
            const float* xi = l == 0 ? args.in[0] : args.out;
            for (int m = gw; m < M; m += NGW)
                resnorm_row(xi + (size_t)m * D_MODEL, (const half_t*)(ws + WS_OUT) + (size_t)m * D_MODEL, args.in[2] + l * D_MODEL, args.out + (size_t)m * D_MODEL,
                            args.in[1] + (l + 1 < DEPTH ? l + 1 : l) * D_MODEL, l + 1 < DEPTH ? XN + (size_t)m * D_MODEL : nullptr, lane_);
        }
        SEAM(pb + 5);
    }
#undef IN
#undef SEAM
}

__device__ __forceinline__ float sigmoidf_(float x) { return 1.f / (1.f + expf(-x)); }
__device__ __forceinline__ float gelu_tanh(float x) { const float c = 0.7978845608028654f; return 0.5f * x * (1.f + tanhf(c * (x + 0.044715f * x * x * x))); }
__global__ void __launch_bounds__(256) k_attn16(const half_t* Q, const half_t* K, const half_t* V, const float* kmean, const half_t* ZA, half_t* OSA) {
    __shared__ float qs[HD];
    __shared__ float sc[4 * MOBA_BLK];
    __shared__ float red[256];
    __shared__ int selb[4];
    __shared__ float gate[NBLK];
    const int t = blockIdx.x, h = blockIdx.y, b = blockIdx.z, tid = threadIdx.x;
    const int m = b * SEQ + t, own = t / MOBA_BLK;
    const size_t hb = (size_t)(b * NH + h) * SEQ * HD;
    if (tid < HD) qs[tid] = (float)Q[hb + (size_t)t * HD + tid];
    __syncthreads();
    if (tid < NBLK) { float g = 0.f; const float* km = kmean + ((size_t)(b * NH + h) * NBLK + tid) * HD; for (int d = 0; d < HD; ++d) g += qs[d] * (km[d] + km[d + BATCH * NH * NBLK * HD]); gate[tid] = g; }
    __syncthreads();
    if (tid == 0) {
        selb[0] = own; int ns = 1; unsigned used = 0u;
        for (int k = 0; k < TOPK; ++k) { int best = -1; float bv = 0.f; for (int j = 0; j < own; ++j) if (!((used >> j) & 1u) && (best < 0 || gate[j] > bv)) { best = j; bv = gate[j]; }
            if (best >= 0) { used |= 1u << best; selb[ns++] = best; } }
        for (; ns < 4; ++ns) selb[ns] = -1;
    }
    __syncthreads();
    const float scale = 0.08838834764831845f;
    float mx = -INFINITY;
    for (int s = 0; s < 4; ++s) {
        const int blk = selb[s]; float v = -INFINITY;
        if (blk >= 0) { const int kp = blk * MOBA_BLK + tid;
            if (kp <= t) { const half_t* kr = K + hb + (size_t)kp * HD; float a = 0.f; for (int d = 0; d < HD; ++d) a += qs[d] * (float)kr[d]; v = a * scale; } }
        sc[s * MOBA_BLK + tid] = v; mx = fmaxf(mx, v);
    }
    red[tid] = mx; __syncthreads();
    for (int o = 128; o > 0; o >>= 1) { if (tid < o) red[tid] = fmaxf(red[tid], red[tid + o]); __syncthreads(); }
    mx = red[0]; __syncthreads();
    float sum = 0.f;
    for (int s = 0; s < 4; ++s) { const float v = sc[s * MOBA_BLK + tid]; const float p = (v == -INFINITY) ? 0.f : expf(v - mx); sc[s * MOBA_BLK + tid] = p; sum += p; }
    red[tid] = sum; __syncthreads();
    for (int o = 128; o > 0; o >>= 1) { if (tid < o) red[tid] += red[tid + o]; __syncthreads(); }
    sum = red[0]; __syncthreads();
    const int d = tid & 127, hf = tid >> 7; float acc = 0.f;
    for (int s = 0; s < 4; ++s) { const int blk = selb[s]; if (blk < 0) continue;
        for (int kk = hf * 128; kk < hf * 128 + 128; ++kk) { const float p = sc[s * MOBA_BLK + kk]; if (p != 0.f) acc += p * (float)V[hb + (size_t)(blk * MOBA_BLK + kk) * HD + d]; } }
    red[tid] = acc; __syncthreads();
    if (tid < 128) { const float o = (red[tid] + red[tid + 128]) / sum; const float z = (float)ZA[(size_t)m * ATT_W + h * HD + d];
        OSA[(size_t)m * BR_K + SSM_W + h * HD + d] = (half_t)(o * z); }
}
__global__ void k_s5_scan16(const half_t* U, const float* lam_re, const float* lam_im, const float* log_dt, const float* b_re, const float* b_im, float2* X) {
    const int idx = blockIdx.x * blockDim.x + threadIdx.x;
    if (idx >= BATCH * SSM_G * SSM_P) return;
    const int p = idx % SSM_P, g = (idx / SSM_P) % SSM_G, b = idx / (SSM_P * SSM_G);
    const float lr = lam_re[g * SSM_P + p], li = lam_im[g * SSM_P + p], dt = expf(log_dt[g]);
    const float mag = expf(lr * dt), are = mag * cosf(li * dt), aim = mag * sinf(li * dt);
    const float den = lr * lr + li * li, nr = are - 1.f, ni = aim;
    const float fre = (nr * lr + ni * li) / den, fim = (ni * lr - nr * li) / den;
    float bbr[SSM_GC], bbi[SSM_GC];
#pragma unroll
    for (int c = 0; c < SSM_GC; ++c) { const float br = b_re[(g * SSM_P + p) * SSM_GC + c], bi = b_im[(g * SSM_P + p) * SSM_GC + c]; bbr[c] = fre * br - fim * bi; bbi[c] = fre * bi + fim * br; }
    float xr = 0.f, xi = 0.f;
    for (int t = 0; t < SEQ; ++t) {
        const half_t* u = U + (size_t)(b * SEQ + t) * SSM_W + g * SSM_GC; float ur = 0.f, ui = 0.f;
#pragma unroll
        for (int c = 0; c < SSM_GC; ++c) { const float uc = (float)u[c]; ur += bbr[c] * uc; ui += bbi[c] * uc; }
        const float nxr = are * xr - aim * xi + ur, nxi = are * xi + aim * xr + ui; xr = nxr; xi = nxi;
        X[((size_t)(b * SEQ + t) * SSM_G + g) * SSM_P + p] = make_float2(xr, xi);
    }
}
__global__ void k_s5_out16(const half_t* U, const float2* X, const float* c_re, const float* c_im, const float* d_skip, half_t* YS) {
    const int idx = blockIdx.x * blockDim.x + threadIdx.x;
    if (idx >= M * SSM_W) return;
    const int ch = idx % SSM_W, m = idx / SSM_W, g = ch / SSM_GC, c = ch % SSM_GC;
    const float2* x = X + ((size_t)m * SSM_G + g) * SSM_P; float y = 0.f;
    for (int p = 0; p < SSM_P; ++p) y += x[p].x * c_re[(g * SSM_GC + c) * SSM_P + p] - x[p].y * c_im[(g * SSM_GC + c) * SSM_P + p];
    y += d_skip[ch] * (float)U[(size_t)m * SSM_W + ch];
    YS[idx] = (half_t)gelu_tanh(y);
}


extern "C" void kernel_launch(void* const* d_in, const int* in_sizes, int n_in, void* d_out, int out_size, void* d_ws, size_t ws_size, hipStream_t stream) {
    static int grid = 0;
    if (grid == 0) {
        if (n_in != 17 || out_size != M * D_MODEL || ws_size < WS_END) { fprintf(stderr, "kernel_launch: unexpected shapes (n_in %d out %d ws %zu need %zu)\n", n_in, out_size, ws_size, (size_t)WS_END); grid = -1; return; }
        int dev = 0, cus = 0, per_cu = 0;
        if (hipGetDevice(&dev) != hipSuccess || hipDeviceGetAttribute(&cus, hipDeviceAttributeMultiprocessorCount, dev) != hipSuccess) { grid = -1; return; }
        if (hipFuncSetAttribute((const void*)mk_fwd, hipFuncAttributeMaxDynamicSharedMemorySize, LDS_BYTES) != hipSuccess) { fprintf(stderr, "kernel_launch: hipFuncSetAttribute failed\n"); grid = -1; return; }
        if (hipOccupancyMaxActiveBlocksPerMultiprocessor(&per_cu, (const void*)mk_fwd, NWAVES * 64, LDS_BYTES) != hipSuccess || per_cu < 1) fprintf(stderr, "kernel_launch: occupancy query says %d\n", per_cu);
        (void)hipGetLastError();
        grid = cus;
    }
    if (grid < 0) return;
    (void)hipMemsetAsync((char*)d_ws + WS_CTL, 0, CTL_ZERO_BYTES, stream);
    Args a{};
    for (int i = 0; i < 17; ++i) a.in[i] = (const float*)d_in[i];
    a.out = (float*)d_out; a.ws = (unsigned char*)d_ws;
    unsigned char* ws = (unsigned char*)d_ws;
    auto run = [&](int lo, int hi) { a.ph_lo = lo; a.ph_hi = hi; hipLaunchKernelGGL(mk_fwd, dim3(grid), dim3(NWAVES * 64), LDS_BYTES, stream, a); };
    run(0, N_PHASES);
}
```
